# Optimizing an MI355X kernel written in HIP

```python
import jax, jax.numpy as jnp
from jax import lax
import numpy as np

D_MODEL = 1024
BATCH = 4
SEQ = 4096
DEPTH = 2

D_POOL = D_MODEL // 2
POOL_WINDOWS = (2, 4, 8, 16)
N_POOL_GROUPS = len(POOL_WINDOWS)
POOL_GROUP = D_POOL // N_POOL_GROUPS
D_ATTN = D_MODEL // 2
HEAD_DIM = 64
N_HEADS = D_ATTN // HEAD_DIM
DILATED_PATTERNS = ((128, 1), (512, 4), (2048, 16))
Q_BLOCK = 128
D_IN = D_POOL + 3 * D_ATTN
D_FF = 2816
N_EXPERTS = 8
TOP_K = 2
D_FF_EXPERT = 3584
EPS = 1e-6
N_DENSE = (DEPTH + 1) // 2
N_MOE = DEPTH // 2

kernel_name = "hybrid_pool_dilated_attn_moe_block"


def rmsnorm(x, g):
    xf = x.astype(jnp.float32)
    y = xf * lax.rsqrt(jnp.mean(xf * xf, axis=-1, keepdims=True) + EPS)
    return (y * g.astype(jnp.float32)).astype(x.dtype)


def pool_mixer(u, w_pool, pool_scale):
    B, S, _ = u.shape
    uf = u.astype(jnp.float32)
    c = jnp.concatenate([jnp.zeros((B, 1, D_POOL), jnp.float32), jnp.cumsum(uf, axis=1)], axis=1)
    t = jnp.arange(S)
    diffs = []
    for gi, w in enumerate(POOL_WINDOWS):
        sl = slice(gi * POOL_GROUP, (gi + 1) * POOL_GROUP)
        cg = c[..., sl]
        lo = jnp.maximum(t + 1 - w, 0)
        win_sum = cg[:, 1:] - cg[:, lo]
        cnt = (t + 1 - lo).astype(jnp.float32)[None, :, None]
        diffs.append(win_sum / cnt - uf[..., sl])
    d = jnp.stack(diffs, axis=2).astype(u.dtype)
    z = jnp.einsum('bsgc,gce->bsge', d, w_pool).reshape(B, S, D_POOL)
    return rmsnorm(z, pool_scale)


def dilated_attention(q, k, v):
    B, H, S, Dh = q.shape
    nb = S // Q_BLOCK
    scale = HEAD_DIM ** -0.5
    qb = q.reshape(B, H, nb, Q_BLOCK, Dh).transpose(2, 0, 1, 3, 4)

    def block(args):
        bi, qblk = args
        pos = bi * Q_BLOCK + jnp.arange(Q_BLOCK)
        outs, lses = [], []
        for window, dil in DILATED_PATTERNS:
            n_keys = window // dil + 1
            kidx = pos[:, None] - dil * jnp.arange(n_keys)[None, :]
            valid = kidx >= 0
            kidx = jnp.maximum(kidx, 0)
            kg = k[:, :, kidx]
            vg = v[:, :, kidx]
            s = jnp.einsum('bhqd,bhqjd->bhqj', qblk, kg).astype(jnp.float32) * scale
            s = jnp.where(valid[None, None], s, -jnp.inf)
            m = jnp.max(s, axis=-1, keepdims=True)
            p = jnp.exp(s - m)
            den = jnp.sum(p, axis=-1, keepdims=True)
            o = jnp.einsum('bhqj,bhqjd->bhqd', p, vg.astype(jnp.float32)) / den
            outs.append(o)
            lses.append(m + jnp.log(den))
        wts = jax.nn.softmax(jnp.concatenate(lses, axis=-1), axis=-1)
        o = jnp.einsum('bhqp,pbhqd->bhqd', wts, jnp.stack(outs, axis=0))
        return o.astype(q.dtype)

    ob = lax.map(block, (jnp.arange(nb), qb))
    return ob.transpose(1, 2, 0, 3, 4).reshape(B, H, S, Dh)


def hybrid_mixer(h, w_in, w_pool, pool_scale, attn_gain, w_out):
    B, S, _ = h.shape
    proj = h @ w_in
    u = proj[..., :D_POOL]
    q, k, v = jnp.split(proj[..., D_POOL:], 3, axis=-1)
    to_heads = lambda t: t.reshape(B, S, N_HEADS, HEAD_DIM).transpose(0, 2, 1, 3)
    y_a = pool_mixer(u, w_pool, pool_scale)
    o = dilated_attention(to_heads(q), to_heads(k), to_heads(v))
    y_b = rmsnorm(o.transpose(0, 2, 1, 3).reshape(B, S, D_ATTN), attn_gain)
    return jnp.concatenate([y_a, y_b], axis=-1) @ w_out


def swiglu(h, wg, wu, wd):
    return (jax.nn.silu(h @ wg) * (h @ wu)) @ wd


def moe_swiglu(h, w_router, wg, wu, wd):
    B, S, D = h.shape
    xt = h.reshape(-1, D)
    logits = (xt @ w_router).astype(jnp.float32)
    top_v, top_i = lax.top_k(logits, TOP_K)
    gates = jax.nn.softmax(top_v, axis=-1)
    gate = jnp.sum(jax.nn.one_hot(top_i, N_EXPERTS, dtype=jnp.float32) * gates[..., None], axis=1)
    y = jnp.zeros_like(xt)
    for e in range(N_EXPERTS):
        y = y + gate[:, e:e + 1].astype(xt.dtype) * swiglu(xt, wg[e], wu[e], wd[e])
    return y.reshape(B, S, D)


def setup_inputs(seed: int = 0) -> dict:
    key = jax.random.key(seed)
    ks = jax.random.split(key, 20)
    f32 = jnp.float32
    nrm = lambda k, shape, fan_in: jax.random.normal(k, shape, f32) * (fan_in ** -0.5)
    gain = lambda k, shape: 1.0 + 0.05 * jax.random.normal(k, shape, f32)
    return {
        "x": jax.random.normal(ks[0], (BATCH, SEQ, D_MODEL), f32),
        "norm_mix": gain(ks[1], (DEPTH, D_MODEL)),
        "w_in": nrm(ks[2], (DEPTH, D_MODEL, D_IN), D_MODEL),
        "w_pool": nrm(ks[3], (DEPTH, N_POOL_GROUPS, POOL_GROUP, POOL_GROUP), POOL_GROUP),
        "pool_scale": gain(ks[4], (DEPTH, D_POOL)),
        "attn_gain": gain(ks[5], (DEPTH, D_ATTN)),
        "w_out": nrm(ks[6], (DEPTH, D_MODEL, D_MODEL), D_MODEL),
        "norm_ffn": gain(ks[7], (DEPTH, D_MODEL)),
        "ffn_wg": nrm(ks[8], (N_DENSE, D_MODEL, D_FF), D_MODEL),
        "ffn_wu": nrm(ks[9], (N_DENSE, D_MODEL, D_FF), D_MODEL),
        "ffn_wd": nrm(ks[10], (N_DENSE, D_FF, D_MODEL), D_FF),
        "w_router": nrm(ks[11], (N_MOE, D_MODEL, N_EXPERTS), D_MODEL),
        "moe_wg": nrm(ks[12], (N_MOE, N_EXPERTS, D_MODEL, D_FF_EXPERT), D_MODEL),
        "moe_wu": nrm(ks[13], (N_MOE, N_EXPERTS, D_MODEL, D_FF_EXPERT), D_MODEL),
        "moe_wd": nrm(ks[14], (N_MOE, N_EXPERTS, D_FF_EXPERT, D_MODEL), D_FF_EXPERT),
        "final_norm": gain(ks[15], (D_MODEL,)),
    }


def reference(x, norm_mix, w_in, w_pool, pool_scale, attn_gain, w_out, norm_ffn,
              ffn_wg, ffn_wu, ffn_wd, w_router, moe_wg, moe_wu, moe_wd, final_norm):
    for l in range(DEPTH):
        h = rmsnorm(x, norm_mix[l])
        x = x + hybrid_mixer(h, w_in[l], w_pool[l], pool_scale[l], attn_gain[l], w_out[l])
        h = rmsnorm(x, norm_ffn[l])
        if l % 2 == 0:
            i = l // 2
            x = x + swiglu(h, ffn_wg[i], ffn_wu[i], ffn_wd[i])
        else:
            i = l // 2
            x = x + moe_swiglu(h, w_router[i], moe_wg[i], moe_wu[i], moe_wd[i])
    return rmsnorm(x, final_norm)
```

```cpp
#include <hip/hip_runtime.h>
#include <hip/hip_bf16.h>
#include <cstdio>
#include <cstdint>

#ifndef PROBE_MASK
#define PROBE_MASK 0u
#endif
#ifndef MK_ONE_LAUNCH
#define MK_ONE_LAUNCH 1
#endif

constexpr int BATCH = 4, SEQ = 4096, D = 1024, M = BATCH * SEQ;
constexpr int DPOOL = 512, DATT = 512, NH = 8, HD = 64, DIN = 2048, PGRP = 128;
constexpr int DFF = 2816, NE = 8, DFE = 3584;
constexpr int PPITCH = DIN + 64;
constexpr float EPS = 1e-6f;
constexpr float C2 = 0.125f * 1.4426950408889634f;

#define GAS __attribute__((address_space(1)))
#define LAS __attribute__((address_space(3)))
typedef unsigned short bf16;
typedef unsigned v4u __attribute__((ext_vector_type(4)));
typedef unsigned v2u __attribute__((ext_vector_type(2)));
typedef float f32x4 __attribute__((ext_vector_type(4)));
typedef float f32x2 __attribute__((ext_vector_type(2)));
typedef short bf16x8 __attribute__((ext_vector_type(8)));
typedef short s16x4 __attribute__((ext_vector_type(4)));
typedef __bf16 bf16x2_t __attribute__((ext_vector_type(2)));
typedef GAS unsigned gu32;
#define RLX_AGENT __ATOMIC_RELAXED, __HIP_MEMORY_SCOPE_AGENT
#define LDS_WAIT() asm volatile("s_waitcnt lgkmcnt(0)" ::: "memory")
#define VM_WAIT() asm volatile("s_waitcnt vmcnt(0)" ::: "memory")
__device__ __forceinline__ unsigned cvtpk(float lo, float hi) { f32x2 v = {lo, hi}; bf16x2_t b = __builtin_convertvector(v, bf16x2_t); return __builtin_bit_cast(unsigned, b); }
constexpr float SX8 = 4.f, SW1_8 = 128.f, SH8 = 8.f, SW2_8 = 256.f;
__device__ __forceinline__ float clamp8(float x) { return __builtin_amdgcn_fmed3f(x, -448.f, 448.f); }
__device__ __forceinline__ unsigned cvt4_fp8(float a, float b, float c, float d) { int w = 0; w = __builtin_amdgcn_cvt_pk_fp8_f32(clamp8(a), clamp8(b), w, false); w = __builtin_amdgcn_cvt_pk_fp8_f32(clamp8(c), clamp8(d), w, true); return (unsigned)w; }
__device__ __forceinline__ float bflo(unsigned w) { return __uint_as_float(w << 16); }
__device__ __forceinline__ float bfhi(unsigned w) { return __uint_as_float(w & 0xffff0000u); }

namespace pg8 {
#define PG8_LAS __attribute__((address_space(3)))
typedef int v4i_t __attribute__((ext_vector_type(4))); typedef int v8i_t __attribute__((ext_vector_type(8)));
constexpr int BM = 256, BK = 64, HALF = 128, HTB = HALF * BK * 2, STAGE_BYTES = 8 * HTB, NXCD = 8, WGM = 8;
__host__ __device__ __forceinline__ int lds_byte(int r, int c) { const int st = (r >> 4) * 2 + (c >> 5), rr = r & 15, cc = c & 31, ob = rr * 64 + cc * 2; return st * 1024 + (ob ^ (((ob >> 9) & 1) << 5)); }
__host__ __device__ __forceinline__ void stage_rc(int b, int& R, int& C) { const int st = b / 1024, sb = b % 1024, swz = sb ^ (((sb >> 9) & 1) << 5); R = (st >> 1) * 16 + swz / 64; C = (st & 1) * 32 + (swz % 64) / 2; }
__host__ __device__ __forceinline__ int perm32(int rho) { const int n = rho >> 4, i = rho & 15; return 8 * (i >> 2) + 4 * n + (i & 3); }

template <class T> struct identity_t; template <class T> struct identity_t<void(T)> { typedef T type; };
struct Unit { int arow, pn, orow, e, lt, kt0, nkt, slab; };

__device__ __forceinline__ bool static_unit_L(int L, int nM, int nN, int& pm, int& pn) {
    const int nwg = __builtin_amdgcn_readfirstlane(nM * nN); if (L >= nwg) return false;
    int wgid = L; { const int q = nwg / NXCD, r = nwg % NXCD, xcd = wgid % NXCD, off = wgid / NXCD; wgid = (xcd < r ? xcd * (q + 1) : r * (q + 1) + (xcd - r) * q) + off; }
    const int nig = WGM * nN, gid = wgid / nig, fm = gid * WGM, gsz = (nM - fm) < WGM ? (nM - fm) : WGM;
    pm = fm + ((wgid % nig) % gsz); pn = (wgid % nig) / gsz; return true;
}
__device__ __forceinline__ bool static_unit(int i, int G, int c, int nM, int nN, int& pm, int& pn) { return static_unit_L(i * G + c, nM, nN, pm, pn); }

struct ProbDense {
    const char* A; const char* B; int K, nM, nN, G, c; int i0 = 0, nmax = 1 << 30; const float* sso = nullptr; PG8_LAS float* rtab = nullptr; bool ablk = false;
    __device__ __forceinline__ bool next(int i, Unit& u) const { int pm, pn; if (i >= nmax || !static_unit(i0 + i, G, c, nM, nN, pm, pn)) return false; u.arow = pm; u.pn = pn; u.orow = pm; u.e = 0; u.lt = 0; u.kt0 = 0; u.nkt = K / BK; u.slab = -1; return true; }
    __device__ __forceinline__ const char* a_base(const Unit& u) const { return A + (size_t)u.arow * 256 * K * 2; }
    __device__ __forceinline__ const char* b_base(const Unit& u) const { return B + (size_t)u.pn * 256 * K * 2; }
};
template <int AMODE> struct ProbMoE {
    const char* A; const char* B; size_t bes; int K, nT, nN, G, c; const PG8_LAS int* tab;
    bool ablk = (AMODE == 1);
    int* ovf = nullptr;
    __device__ __forceinline__ bool next(int i, Unit& u) const {
        int pm, pn, kt0 = 0, nkt = K / BK, slab = -1;
        const int U = nT * nN, L = i * G + c;
        int umain = U, R = 0, S = 1;
        if (ovf) { umain = (U / G) * G; R = U - umain; S = (R > 0 && R * 7 <= G) ? 7 : ((R > 0 && R * 2 <= G) ? 2 : 1); if (S == 1) umain = U; }
        if (L < umain) { if (!static_unit_L(L, nT, nN, pm, pn)) return false; }
        else { const int idx = L - umain; if (idx >= R * S) return false; const int v = idx % R, sl = idx / R;
            if (!static_unit_L(umain + v, nT, nN, pm, pn)) return false;
            nkt = (K / BK) / S; kt0 = sl * nkt; slab = v * S + sl; if (sl == 0 && threadIdx.x == 0) ovf[pm * nN + pn] = v + 1; }
        const int t = pm; int e = 0;
#pragma unroll
        for (int k = 1; k < NE; ++k) e = (t >= tab[k]) ? k : e;
        e = __builtin_amdgcn_readfirstlane(e);
        const int tse = __builtin_amdgcn_readfirstlane(tab[e]);
        u.arow = pm; u.pn = pn; u.orow = t; u.e = e; u.lt = t - tse; u.kt0 = kt0; u.nkt = nkt; u.slab = slab; return true;
    }
    __device__ __forceinline__ const char* a_base(const Unit& u) const { return AMODE == 0 ? A + ((size_t)u.e * M + (size_t)u.lt * 256) * K * 2 : A + (size_t)u.arow * 256 * K * 2; }
    __device__ __forceinline__ const char* b_base(const Unit& u) const { return B + (size_t)u.e * bes + (size_t)u.pn * 256 * K * 2; }
};

__device__ __forceinline__ void row_scales(const float* SS, PG8_LAS float* rtab, int orow, int wr, int wc, int fr, int fq) {
    const int t = (wr * 4 + wc) * 64 + fq * 16 + fr, row = t >> 1, half = t & 1;
    const f32x4 a = *(const f32x4*)(SS + (size_t)(orow * BM + row) * 16 + half * 8), b = *(const f32x4*)(SS + (size_t)(orow * BM + row) * 16 + half * 8 + 4);
    float sm = ((a[0] + a[1]) + (a[2] + a[3])) + ((b[0] + b[1]) + (b[2] + b[3]));
    sm += __shfl_xor(sm, 1);
    if (half == 0) rtab[row] = 1.f / sqrtf(sm * (1.f / 1024.f) + 1e-6f);
    asm volatile("s_waitcnt lgkmcnt(0)\n\ts_barrier" ::: "memory");
}
struct EpiBf16 {
    static constexpr bool PERM = true;
    bf16* O; int ldc; int sc_lo, sc_hi; float scale; const float* SS; PG8_LAS float* rtab; bf16* SLAB = nullptr;
    __device__ __forceinline__ void operator()(const f32x4 (&acc)[2][2][4][2], const Unit& u, int wr, int wc, int fr, int fq) const {
        int row0 = u.orow * BM + wr * 64 + fr, col0 = u.pn * BM + wc * 32 + 8 * fq; bf16* Ob = O; int ld = ldc;
        if (u.slab >= 0) { Ob = SLAB + (size_t)u.slab * (BM * BM); ld = BM; row0 = wr * 64 + fr; col0 = wc * 32 + 8 * fq; }
        const float sc0 = (u.pn >= sc_lo && u.pn < sc_hi) ? scale : 1.f;
        if (SS) row_scales(SS, rtab, u.orow, wr, wc, fr, fq);
#pragma unroll
        for (int ai = 0; ai < 2; ++ai)
#pragma unroll
            for (int m = 0; m < 4; ++m) { bf16* rowp = Ob + (size_t)(row0 + ai * HALF + m * 16) * ld + col0; const float sc = SS ? sc0 * rtab[wr * 64 + fr + ai * HALF + m * 16] : sc0;
#pragma unroll
                for (int bj = 0; bj < 2; ++bj) { const f32x4 v0 = acc[ai][bj][m][0] * sc, v1 = acc[ai][bj][m][1] * sc;
                    v4u w; w.x = cvtpk(v0[0], v0[1]); w.y = cvtpk(v0[2], v0[3]); w.z = cvtpk(v1[0], v1[1]); w.w = cvtpk(v1[2], v1[3]);
                    *(v4u*)(rowp + bj * HALF) = w; } }
    }
};
template <bool BASE_F32, bool HAS_X8 = false, bool SCALED = false> struct EpiRes {
    static constexpr bool PERM = true;
    const void* base; bf16* X; int ldc; float* SS; unsigned char* X8 = nullptr; float ascale = 1.f;
    __device__ __forceinline__ void operator()(const f32x4 (&acc)[2][2][4][2], const Unit& u, int wr, int wc, int fr, int fq) const {
        const int row0 = u.orow * BM + wr * 64 + fr, col0 = u.pn * BM + wc * 32 + 8 * fq;
#pragma unroll
        for (int ai = 0; ai < 2; ++ai)
#pragma unroll
            for (int m = 0; m < 4; ++m) { const size_t off = (size_t)(row0 + ai * HALF + m * 16) * ldc + col0; float sq = 0.f;
#pragma unroll
                for (int bj = 0; bj < 2; ++bj) { f32x4 b0, b1;
                    if (BASE_F32) { b0 = *(const f32x4*)((const float*)base + off + bj * HALF); b1 = *(const f32x4*)((const float*)base + off + bj * HALF + 4); }
                    else { const v4u w = *(const v4u*)((const bf16*)base + off + bj * HALF); b0 = (f32x4){bflo(w.x), bfhi(w.x), bflo(w.y), bfhi(w.y)}; b1 = (f32x4){bflo(w.z), bfhi(w.z), bflo(w.w), bfhi(w.w)}; }
                    const f32x4 x0 = SCALED ? b0 + acc[ai][bj][m][0] * ascale : b0 + acc[ai][bj][m][0], x1 = SCALED ? b1 + acc[ai][bj][m][1] * ascale : b1 + acc[ai][bj][m][1];
                    v4u o; o.x = cvtpk(x0[0], x0[1]); o.y = cvtpk(x0[2], x0[3]); o.z = cvtpk(x1[0], x1[1]); o.w = cvtpk(x1[2], x1[3]);
                    *(v4u*)(X + off + bj * HALF) = o;
                    if constexpr (HAS_X8) { v2u o8; o8.x = cvt4_fp8(x0[0] * SX8, x0[1] * SX8, x0[2] * SX8, x0[3] * SX8); o8.y = cvt4_fp8(x1[0] * SX8, x1[1] * SX8, x1[2] * SX8, x1[3] * SX8); *(v2u*)(X8 + off + bj * HALF) = o8; }
                    sq += ((x0[0] * x0[0] + x0[1] * x0[1]) + (x0[2] * x0[2] + x0[3] * x0[3])) + ((x1[0] * x1[0] + x1[1] * x1[1]) + (x1[2] * x1[2] + x1[3] * x1[3])); }
                if (SS) { sq += __shfl_xor(sq, 16); sq += __shfl_xor(sq, 32); if (fq == 0) SS[(size_t)(row0 + ai * HALF + m * 16) * 16 + u.pn * 4 + wc] = sq; } }
    }
};
struct EpiSwiGLU {
    static constexpr bool PERM = true;
    bf16* H; int ldh; const float* SS; PG8_LAS float* rtab;
    __device__ __forceinline__ void operator()(const f32x4 (&acc)[2][2][4][2], const Unit& u, int wr, int wc, int fr, int fq) const {
        const int row0 = u.orow * BM + wr * 64 + fr, col0 = u.pn * HALF + wc * 32 + 8 * fq;
        if (SS) row_scales(SS, rtab, u.orow, wr, wc, fr, fq);
#pragma unroll
        for (int ai = 0; ai < 2; ++ai)
#pragma unroll
            for (int m = 0; m < 4; ++m) { bf16* rowp = H + (size_t)(row0 + ai * HALF + m * 16) * ldh + col0; const float rs = SS ? rtab[wr * 64 + fr + ai * HALF + m * 16] : 1.f;
                const float c1 = -1.4426950408889634f * rs, c2 = rs * rs; unsigned w[4];
#pragma unroll
                for (int n = 0; n < 2; ++n)
#pragma unroll
                    for (int jp = 0; jp < 2; ++jp) { const f32x2 g = {acc[ai][0][m][n][2 * jp], acc[ai][0][m][n][2 * jp + 1]}, up = {acc[ai][1][m][n][2 * jp], acc[ai][1][m][n][2 * jp + 1]};
                        const f32x2 t = g * c1; f32x2 e; e.x = __builtin_amdgcn_exp2f(t.x); e.y = __builtin_amdgcn_exp2f(t.y); const f32x2 d = e + 1.0f; f32x2 r; r.x = __builtin_amdgcn_rcpf(d.x); r.y = __builtin_amdgcn_rcpf(d.y);
                        const f32x2 hh = (g * up) * (r * c2); w[n * 2 + jp] = cvtpk(hh.x, hh.y); }
                v4u wv; wv.x = w[0]; wv.y = w[1]; wv.z = w[2]; wv.w = w[3];
                *(v4u*)rowp = wv; }
    }
};
struct EpiSwiGLU8 {
    static constexpr bool PERM = true;
    unsigned char* H; int ldh; float inscale; const float* SS = nullptr; PG8_LAS float* rtab = nullptr;
    __device__ __forceinline__ void operator()(const f32x4 (&acc)[2][2][4][2], const Unit& u, int wr, int wc, int fr, int fq) const {
        const int row0 = u.orow * BM + wr * 64 + fr, col0 = u.pn * HALF + wc * 32 + 8 * fq;
        if (SS) row_scales(SS, rtab, u.orow, wr, wc, fr, fq);
#pragma unroll
        for (int ai = 0; ai < 2; ++ai)
#pragma unroll
            for (int m = 0; m < 4; ++m) { unsigned char* rowp = H + ((size_t)u.orow * (ldh / 128) + u.pn) * 32768 + wc * 8192 + (wr * 64 + fr + ai * HALF + m * 16) * 32 + 8 * fq; unsigned wq[2];
                const float is_ = SS ? inscale * rtab[wr * 64 + fr + ai * HALF + m * 16] : inscale; const float c1 = -1.4426950408889634f * is_, c2 = is_ * is_ * SH8;
#pragma unroll
                for (int n = 0; n < 2; ++n) { f32x2 hh[2];
#pragma unroll
                    for (int jp = 0; jp < 2; ++jp) { const f32x2 g = {acc[ai][0][m][n][2 * jp], acc[ai][0][m][n][2 * jp + 1]}, up = {acc[ai][1][m][n][2 * jp], acc[ai][1][m][n][2 * jp + 1]};
                        const f32x2 t = g * c1; f32x2 e; e.x = __builtin_amdgcn_exp2f(t.x); e.y = __builtin_amdgcn_exp2f(t.y); const f32x2 d = e + 1.0f; f32x2 r; r.x = __builtin_amdgcn_rcpf(d.x); r.y = __builtin_amdgcn_rcpf(d.y);
                        hh[jp] = (g * up) * (r * c2); }
                    wq[n] = cvt4_fp8(hh[0].x, hh[0].y, hh[1].x, hh[1].y); }
                v2u w; w.x = wq[0]; w.y = wq[1];
                __builtin_nontemporal_store(w, (v2u*)rowp); }
    }
};

template <bool FP8, bool MIDK = false, class Prob, class Epi>
__device__ __forceinline__ void gemm_phase(PG8_LAS unsigned char* lds, const Prob& P, const Epi& E) {
    int tid = threadIdx.x; asm volatile("" : "+v"(tid));
    const int wid = __builtin_amdgcn_readfirstlane(tid >> 6), lane = tid & 63, wr = wid >> 2, wc = wid & 3, fr = lane & 15, fq = lane >> 4;
    const int K = P.K;
    const bool ablk = P.ablk;
    int Rr[2], Cc[2]; unsigned voffA[2], voffB[2];
    stage_rc(tid * 16, Rr[0], Cc[0]); Rr[1] = Rr[0] + 64; Cc[1] = Cc[0];
#pragma unroll
    for (int i = 0; i < 2; ++i) { const int Rb = Epi::PERM ? ((Rr[i] & ~31) + perm32(Rr[i] & 31)) : Rr[i]; voffA[i] = ablk ? (unsigned)(((2 * Cc[i]) >> 5) * 8192 + Rr[i] * 32 + ((2 * Cc[i]) & 31)) : (unsigned)(Rr[i] * K + Cc[i]) * 2u; voffB[i] = (unsigned)(Rb * K + Cc[i]) * 2u; }
    const size_t kstep = (size_t)(BK * 2), kstepA = ablk ? (size_t)32768 : kstep;
    const size_t hstep = (size_t)HALF * K * 2, qstep = (size_t)64 * K * 2, hstepA = ablk ? (size_t)4096 : hstep, qstepA = ablk ? (size_t)2048 : qstep;
    const unsigned ldsw = (unsigned)wid * 1024u;
    const int aoff = lds_byte(wr * 64 + fr, fq * 8), boff = lds_byte(wc * 32 + fr, fq * 8);
#define PG8_SA(b, h) (((b) * 2 + (h)) * HTB)
#define PG8_SB(b, h) ((4 + (b) * 2 + (h)) * HTB)
#define PG8_STAGE_Q(bufoff, gbase, voff, qs) do { unsigned _o = (voff)[0]; asm volatile("" : "+v"(_o));     \
        _Pragma("unroll") for (int _i = 0; _i < 2; ++_i) \
        __builtin_amdgcn_global_load_lds((const unsigned*)((const char*)(gbase) + (size_t)_i * (qs) + _o), (PG8_LAS unsigned*)(lds + (bufoff) + ldsw + _i * 8192), 16, 0, 0); } while (0)
#define PG8_STAGE(bufoff, gbase, voff) PG8_STAGE_Q(bufoff, gbase, voff, qstep)
#define PG8_STAGE_A(bufoff, a, h, goff) PG8_STAGE_Q(bufoff, (a) + (h) * hstepA, voffA, qstepA)
#define PG8_STAGE_A2(bufoff, a, h) PG8_STAGE_Q(bufoff, (a) + (h) * hstepA, voffA, qstepA)
#define PG8_LDA(dst, b, h) do { _Pragma("unroll") for (int m = 0; m < 4; ++m) _Pragma("unroll") for (int k = 0; k < 2; ++k) dst[m][k] = *(const PG8_LAS bf16x8*)(lds + PG8_SA(b, h) + aoff + m * 2048 + k * 1024); } while (0)
#define PG8_LDB(dst, b, h) do { _Pragma("unroll") for (int n = 0; n < 2; ++n) _Pragma("unroll") for (int k = 0; k < 2; ++k) dst[n][k] = *(const PG8_LAS bf16x8*)(lds + PG8_SB(b, h) + boff + n * 2048 + k * 1024); } while (0)
#define PG8_MMA(ai, bj, At, Bt) do { __builtin_amdgcn_s_setprio(1); _Pragma("unroll") for (int m = 0; m < 4; ++m) _Pragma("unroll") for (int n = 0; n < 2; ++n) _Pragma("unroll") for (int k = 0; k < 2; ++k) \
        acc[ai][bj][m][n] = __builtin_amdgcn_mfma_f32_16x16x32_bf16(Bt[n][k], At[m][k], acc[ai][bj][m][n], 0, 0, 0); __builtin_amdgcn_s_setprio(0); } while (0)
#define PG8_CAT8(x, y) __builtin_shufflevector((x), (y), 0, 1, 2, 3, 4, 5, 6, 7)
#define PG8_LDA8(dst, b, h) do { _Pragma("unroll") for (int m = 0; m < 4; ++m) dst[m] = PG8_CAT8(*(const PG8_LAS v4i_t*)(lds + PG8_SA(b, h) + aoff + m * 2048), *(const PG8_LAS v4i_t*)(lds + PG8_SA(b, h) + aoff + m * 2048 + 1024)); } while (0)
#define PG8_LDB8(dst, b, h) do { _Pragma("unroll") for (int n = 0; n < 2; ++n) dst[n] = PG8_CAT8(*(const PG8_LAS v4i_t*)(lds + PG8_SB(b, h) + boff + n * 2048), *(const PG8_LAS v4i_t*)(lds + PG8_SB(b, h) + boff + n * 2048 + 1024)); } while (0)
#define PG8_MMA8(ai, bj, At, Bt) do { __builtin_amdgcn_s_setprio(1); _Pragma("unroll") for (int m = 0; m < 4; ++m) _Pragma("unroll") for (int n = 0; n < 2; ++n) \
        acc[ai][bj][m][n] = __builtin_amdgcn_mfma_scale_f32_16x16x128_f8f6f4(Bt[n], At[m], acc[ai][bj][m][n], 0, 0, 0, 0x7f7f7f7f, 0, 0x7f7f7f7f); __builtin_amdgcn_s_setprio(0); } while (0)
#define PG8_MM(ai, bj, At_, B_) do { if constexpr (FP8) PG8_MMA8(ai, bj, At8, B_##8); else PG8_MMA(ai, bj, At_, B_); } while (0)
#define PG8_LA(b, h) do { if constexpr (FP8) PG8_LDA8(At8, b, h); else PG8_LDA(At, b, h); } while (0)
#define PG8_LB(dst, b, h) do { if constexpr (FP8) PG8_LDB8(dst##8, b, h); else PG8_LDB(dst, b, h); } while (0)
#define PG8_WAIT_V(n) asm volatile("s_waitcnt vmcnt(" #n ")" ::: "memory")
#define PG8_WAIT_L(n) asm volatile("s_waitcnt lgkmcnt(" #n ")" ::: "memory")
#define PG8_BAR __builtin_amdgcn_s_barrier()
#define PG8_SCHED __builtin_amdgcn_sched_barrier(0)
    Unit cur, nxt; int ui = 0;
    if (!P.next(0, cur)) return;
    if constexpr (MIDK) { const int row = tid >> 1, half = tid & 1; const f32x4 a = *(const f32x4*)(P.sso + (size_t)(cur.orow * BM + row) * 8 + half * 4);
        float sm = (a[0] + a[1]) + (a[2] + a[3]); sm += __shfl_xor(sm, 1); if (half == 0) P.rtab[row] = 1.f / sqrtf(sm * (1.f / 512.f) + 1e-6f);
        asm volatile("s_waitcnt lgkmcnt(0)\n\ts_barrier" ::: "memory"); }
    f32x4 acc[2][2][4][2];
#pragma unroll
    for (int a = 0; a < 2; ++a)
#pragma unroll
        for (int b = 0; b < 2; ++b)
#pragma unroll
            for (int m = 0; m < 4; ++m)
#pragma unroll
                for (int n = 0; n < 2; ++n) acc[a][b][m][n] = (f32x4){0.f, 0.f, 0.f, 0.f};
    bf16x8 At[4][2], B0[2][2], B1[2][2]; v8i_t At8[4], B08[2], B18[2];
    const char* cA = P.a_base(cur) + (size_t)cur.kt0 * kstepA; const char* cB = P.b_base(cur) + (size_t)cur.kt0 * kstep;
    PG8_STAGE(PG8_SB(0, 0), cB, voffB); PG8_STAGE(PG8_SB(0, 1), cB + hstep, voffB); PG8_STAGE_A(PG8_SA(0, 0), cA, 0, cOff); PG8_STAGE_A(PG8_SA(0, 1), cA, 1, cOff);
    if (wr == 1) PG8_BAR;
    PG8_WAIT_V(2); PG8_BAR;
    PG8_STAGE(PG8_SB(1, 0), cB + kstep, voffB); PG8_STAGE_A(PG8_SA(1, 0), cA + kstepA, 0, cOff); PG8_STAGE(PG8_SB(1, 1), cB + hstep + kstep, voffB);
    PG8_WAIT_V(6); PG8_BAR;
    for (;;) {
        const bool has_next = P.next(ui + 1, nxt);
        const char* nA = cA; const char* nB = cB;
        if (has_next) { nA = P.a_base(nxt) + (size_t)nxt.kt0 * kstepA; nB = P.b_base(nxt) + (size_t)nxt.kt0 * kstep; }
        const int cnt = cur.nkt;
        for (int t = 0; t < cnt; t += 2) {
            if constexpr (MIDK) { if (t == cnt / 2) {
#pragma unroll
                for (int ai = 0; ai < 2; ++ai)
#pragma unroll
                    for (int m = 0; m < 4; ++m) { const float rsc = P.rtab[wr * 64 + fr + ai * HALF + m * 16];
#pragma unroll
                        for (int bj = 0; bj < 2; ++bj)
#pragma unroll
                            for (int n = 0; n < 2; ++n) acc[ai][bj][m][n] = acc[ai][bj][m][n] * rsc; } } }
            const bool last = (t == cnt - 2);
            const char* a1 = cA + (size_t)(t + 1) * kstepA;
            const char* a2 = last ? nA : cA + (size_t)(t + 2) * kstepA; const char* b2 = last ? nB : cB + (size_t)(t + 2) * kstep;
            const char* a3 = a2 + kstepA; const char* b3 = b2 + kstep;

            PG8_LB(B0, 0, 0); PG8_LB(B1, 0, 1); PG8_SCHED; PG8_LA(0, 0); PG8_STAGE_A(PG8_SA(1, 1), a1, 1, cOff);
            PG8_WAIT_V(8); PG8_WAIT_L(0); PG8_BAR; PG8_MM(0, 0, At, B0); PG8_MM(0, 1, At, B1); PG8_BAR; PG8_SCHED;
            PG8_LA(0, 1); PG8_STAGE(PG8_SB(0, 0), b2, voffB); PG8_STAGE(PG8_SB(0, 1), b2 + hstep, voffB); PG8_STAGE_A2(PG8_SA(0, 0), a2, 0);
            PG8_WAIT_V(8); PG8_WAIT_L(0); PG8_BAR; PG8_MM(1, 0, At, B0); PG8_MM(1, 1, At, B1); PG8_BAR; PG8_SCHED;
            PG8_LB(B0, 1, 0); PG8_LB(B1, 1, 1); PG8_SCHED; PG8_LA(1, 0); PG8_STAGE_A2(PG8_SA(0, 1), a2, 1);
            PG8_WAIT_V(8); PG8_WAIT_L(0); PG8_BAR; PG8_MM(0, 0, At, B0); PG8_MM(0, 1, At, B1); PG8_BAR; PG8_SCHED;
            PG8_LA(1, 1); PG8_STAGE(PG8_SB(1, 0), b3, voffB); PG8_STAGE(PG8_SB(1, 1), b3 + hstep, voffB); PG8_STAGE_A2(PG8_SA(1, 0), a3, 0);
            PG8_WAIT_V(8); PG8_WAIT_L(0); PG8_BAR; PG8_MM(1, 0, At, B0); PG8_MM(1, 1, At, B1); PG8_BAR; PG8_SCHED;
        }
        if (wr == 0) PG8_BAR;
        { int t_ = (int)__builtin_amdgcn_mbcnt_hi(~0u, __builtin_amdgcn_mbcnt_lo(~0u, 0u)); asm volatile("" : "+v"(t_)); E(acc, cur, wr, wc, t_ & 15, (t_ >> 4) & 3); }
        if (!has_next) break;
#pragma unroll
        for (int a = 0; a < 2; ++a)
#pragma unroll
            for (int b = 0; b < 2; ++b)
#pragma unroll
                for (int m = 0; m < 4; ++m)
#pragma unroll
                    for (int n = 0; n < 2; ++n) acc[a][b][m][n] = (f32x4){0.f, 0.f, 0.f, 0.f};
        cur = nxt; cA = nA; cB = nB; ++ui;
        if (wr == 1) PG8_BAR;
    }
    PG8_WAIT_V(0);
    PG8_BAR;
#undef PG8_SA
#undef PG8_SB
#undef PG8_STAGE
#undef PG8_STAGE_Q
#undef PG8_STAGE_A
#undef PG8_STAGE_A2
#undef PG8_LDA
#undef PG8_LDB
#undef PG8_MMA
#undef PG8_MMA8
#undef PG8_MM
#undef PG8_CAT8
#undef PG8_LDA8
#undef PG8_LDB8
#undef PG8_LA
#undef PG8_LB
#undef PG8_WAIT_V
#undef PG8_WAIT_L
#undef PG8_BAR
#undef PG8_SCHED
}
}

constexpr size_t MiB = 1u << 20;
constexpr size_t WS_CTL = 0, CTL_ZERO_BYTES = 1 * MiB;
constexpr size_t SZ_WIN = (size_t)DIN * D * 2, SZ_WOUT = (size_t)D * D * 2, SZ_WGU = (size_t)2 * DFF * D * 2, SZ_WD = (size_t)D * DFF;
constexpr size_t SZ_WGUE = (size_t)2 * DFE * D, SZ_WDE = (size_t)D * DFE;
constexpr size_t WS_WIN = 1 * MiB;
constexpr size_t WS_WOUT = WS_WIN + 2 * SZ_WIN;
constexpr size_t WS_WGU = WS_WOUT + 2 * SZ_WOUT;
constexpr size_t WS_WD = WS_WGU + SZ_WGU;
constexpr size_t WS_WGUE = WS_WD + SZ_WD;
constexpr size_t WS_WDE = WS_WGUE + NE * SZ_WGUE;
constexpr size_t WS_ROUTE = WS_WDE + NE * SZ_WDE;
constexpr size_t SZ_ROUTE = (size_t)M * 32;
constexpr size_t WS_WPOOL = WS_ROUTE + SZ_ROUTE, SZ_WPOOL = (size_t)2 * 4 * PGRP * PGRP * 2;
constexpr size_t WS_SS = WS_WPOOL + SZ_WPOOL, SZ_SS = (size_t)M * 16 * 4;
constexpr size_t WS_SSO = WS_SS + SZ_SS, SZ_SSO = (size_t)M * 8 * 4;
constexpr size_t WS_XN = (WS_SSO + SZ_SSO + MiB - 1) / MiB * MiB;
constexpr size_t WS_ARENA = WS_XN + (size_t)M * D * 2;
constexpr size_t AR_PROJ = 0, AR_O = AR_PROJ + (size_t)M * PPITCH * 2, AR_Y = AR_O + (size_t)M * DATT * 2, AR_MIX_END = AR_Y + (size_t)M * D * 2;
constexpr size_t AR_X8 = 0, AR_H = (size_t)32 * MiB, AR_H_END = AR_H + (size_t)M * DFF;
constexpr int TCH = 136, MAXT = 136;
constexpr size_t AR_XS = 0, AR_YM = 0, AR_HM = (size_t)NE * M * D, AR_MOE_END = AR_HM + (size_t)MAXT * 256 * DFE;
constexpr size_t AR_SLAB = AR_YM + (size_t)MAXT * 256 * D * 2, SZ_SLAB = (size_t)256 * 256 * 256 * 2;
static_assert(AR_SLAB + SZ_SLAB <= (size_t)NE * M * D, "YM and the slabs overlay XS");
constexpr size_t AR_SIZE = AR_MOE_END > AR_MIX_END ? (AR_MOE_END > AR_H_END ? AR_MOE_END : AR_H_END) : (AR_MIX_END > AR_H_END ? AR_MIX_END : AR_H_END);
constexpr size_t WS_END = WS_ARENA + AR_SIZE;
constexpr int CW_TMO = 0, CW_CODE = 1;
constexpr int CW_ECNT = 64;
constexpr int CW_OVF = 256;
constexpr int CW_BAR = 4096;

constexpr int RING_OFF = 0, RING_BYTES = 131072;
constexpr int LDSCTL_OFF = 146432, MISC_OFF = LDSCTL_OFF + 320;
constexpr int LDS_BYTES = 147456;
constexpr int NWAVES = 8;

#define XB_TMO      128
#define XB_XCNT(j)  (256  + 64 * (j))
#define XB_XSUB(j)  (1280 + 64 * (j))
#define XB_XGEN(j)  (2304 + 64 * (j))
#define XB_TOP      3328
#define XB_TOPGEN   3392
#define XCD_BAR_WORDS 3456
#define XB_SPIN_CAP (1u << 18)
__device__ __forceinline__ unsigned xb_ld(unsigned* p)              { return __hip_atomic_load(p, __ATOMIC_RELAXED, __HIP_MEMORY_SCOPE_AGENT); }
__device__ __forceinline__ unsigned xb_add(unsigned* p, unsigned v) { return __hip_atomic_fetch_add(p, v, __ATOMIC_RELAXED, __HIP_MEMORY_SCOPE_AGENT); }
__device__ __forceinline__ unsigned xb_xcc_id() { return (unsigned)__builtin_amdgcn_s_getreg((3 << 11) | 20) & 0xFu; }
#define XB_SPIN(cond, bar) do { unsigned _sp = 0; while (cond) { __builtin_amdgcn_s_sleep(1); \
    if ((++_sp & 255u) == 0u) { if (xb_ld(&(bar)[XB_TMO])) break; if (_sp > XB_SPIN_CAP) { atomicAdd(&(bar)[XB_TMO], 1u); break; } } } } while (0)
struct XcdBarrier { unsigned* bar; unsigned x; volatile LAS unsigned* st; };
__device__ __forceinline__ XcdBarrier xcd_barrier_post(unsigned* bar, volatile LAS unsigned* st) {
    XcdBarrier b; b.bar = bar; b.x = xb_xcc_id(); b.st = st;
    if (threadIdx.x == 0) (void)xb_add(&bar[XB_XCNT(b.x)], 1u);
    return b;
}
__device__ __forceinline__ void xcd_barrier_complete(unsigned* bar, unsigned x, unsigned& nloc, unsigned& nx) {
    const unsigned G = gridDim.x * gridDim.y * gridDim.z;
    unsigned sum, cnt, mine, sp = 0u;
    for (;;) {
        sum = 0u; cnt = 0u; mine = 0u;
#pragma unroll
        for (unsigned j = 0; j < 16; ++j) { const unsigned c = xb_ld(&bar[XB_XCNT(j)]); sum += c; cnt += (c > 0u) ? 1u : 0u; mine = (j == x) ? c : mine; }
        if (sum == G) break;
        __builtin_amdgcn_s_sleep(1);
        if ((++sp & 255u) == 0u) { if (xb_ld(&bar[XB_TMO])) break; if (sp > XB_SPIN_CAP) { atomicAdd(&bar[XB_TMO], 1u); break; } }
    }
    nloc = mine > 0u ? mine : 1u; nx = cnt > 0u ? cnt : 1u;
}
__device__ __forceinline__ void xcd_barrier(const XcdBarrier& b, bool leader) {
    asm volatile("s_waitcnt vmcnt(0)" ::: "memory");
    __syncthreads();
    if (leader) {
        unsigned* bar = b.bar;
        __builtin_amdgcn_s_waitcnt(0);
        unsigned nloc = b.st[0], nx = b.st[1];
        if (nloc == 0u) { xcd_barrier_complete(bar, b.x, nloc, nx); b.st[0] = nloc; b.st[1] = nx; }
        const unsigned old = xb_add(&bar[XB_XSUB(b.x)], 1u);
        const unsigned gen = old / nloc;
        if (old + 1u == (gen + 1u) * nloc) {
            __builtin_amdgcn_fence(__ATOMIC_RELEASE, "agent");
            asm volatile("s_waitcnt vmcnt(0)" ::: "memory");
            const unsigned og = xb_add(&bar[XB_TOP], 1u);
            const unsigned tg = og / nx;
            if (og + 1u == (tg + 1u) * nx) xb_add(&bar[XB_TOPGEN], 1u);
            else XB_SPIN(xb_ld(&bar[XB_TOPGEN]) == tg, bar);
            __builtin_amdgcn_fence(__ATOMIC_ACQUIRE, "agent");
            xb_add(&bar[XB_XGEN(b.x)], 1u);
            asm volatile("s_waitcnt vmcnt(0)" ::: "memory");
        } else {
            XB_SPIN(xb_ld(&bar[XB_XGEN(b.x)]) == gen, bar);
            __builtin_amdgcn_fence(__ATOMIC_ACQUIRE, "agent");
            asm volatile("s_waitcnt vmcnt(0)" ::: "memory");
        }
    }
    __syncthreads();
}

struct Args { const float* in[16]; float* out; unsigned char* ws; int ph_lo, ph_hi; };
struct Frame {
    LAS unsigned char* lds;
    volatile LAS unsigned* MISC;
    gu32* ctl;
    int vcu, G, wave;
};
__device__ __forceinline__ int lane_id() { return (int)__builtin_amdgcn_mbcnt_hi(~0u, __builtin_amdgcn_mbcnt_lo(~0u, 0u)); }
__device__ __forceinline__ int fresh_tid() { int t = threadIdx.x; asm volatile("" : "+v"(t)); return t; }
#define PHASE_IDS() const int tid_ = fresh_tid(); const int ph_lane = tid_ & 63; const int ph_wave = __builtin_amdgcn_readfirstlane(tid_ >> 6); (void)ph_lane; (void)ph_wave
__device__ __forceinline__ float wave_sum(float v) {
#pragma unroll
    for (int o = 1; o < 64; o <<= 1) v += __shfl_xor(v, o);
    return v;
}

struct CvtJob { const float* src; unsigned char* dst; const float* gk; int N, K, r0, k0, f8, gkmax; float scale; int frag; };
__device__ __forceinline__ void cvt_load(const CvtJob& j, f32x4 (&v)[16], int lane) {
    const float* p = j.src + (size_t)(lane >> 4) * j.N + 4 * (lane & 15);
#pragma unroll
    for (int i = 0; i < 16; ++i) v[i] = __builtin_nontemporal_load((const GAS f32x4*)(p + (size_t)(4 * i) * j.N));
}
__device__ __forceinline__ void cvt_store(const CvtJob& j, const f32x4 (&v)[16], LAS float* scr, int lane) {
#pragma unroll
    for (int i = 0; i < 16; ++i) { LAS float* w = scr + (4 * i + (lane >> 4)) * 65 + 4 * (lane & 15); w[0] = v[i].x; w[1] = v[i].y; w[2] = v[i].z; w[3] = v[i].w; }
    LDS_WAIT(); asm volatile("" ::: "memory");
    const int c = lane & 7, nn = lane >> 3; const float sc = j.scale;
    f32x4 ga = (f32x4){sc, sc, sc, sc}, gb = ga;
    if (j.gk && j.k0 < j.gkmax) { ga = ga * *(const GAS f32x4*)(j.gk + j.k0 + 8 * c); gb = gb * *(const GAS f32x4*)(j.gk + j.k0 + 8 * c + 4); }
#pragma unroll
    for (int jj = 0; jj < 8; ++jj) { const int n = nn + 8 * jj; const LAS float* s = scr + (8 * c) * 65 + n;
        const float f0 = s[0] * ga.x, f1 = s[65] * ga.y, f2 = s[130] * ga.z, f3 = s[195] * ga.w, f4 = s[260] * gb.x, f5 = s[325] * gb.y, f6 = s[390] * gb.z, f7 = s[455] * gb.w;
        if (j.f8) { v2u o; o.x = cvt4_fp8(f0, f1, f2, f3); o.y = cvt4_fp8(f4, f5, f6, f7); __builtin_nontemporal_store(o, (GAS v2u*)(j.dst + (size_t)(j.r0 + n) * j.K + j.k0 + 8 * c)); }
        else { v4u o; o.x = cvtpk(f0, f1); o.y = cvtpk(f2, f3); o.z = cvtpk(f4, f5); o.w = cvtpk(f6, f7);
            if (j.frag) { const int e = j.r0 + n, x = (j.k0 >> 3) + c; *(GAS v4u*)(j.dst + ((((e >> 6) * 2 + ((e >> 5) & 1)) * 8 + (x >> 1)) * 1024 + ((x & 1) * 32 + (e & 31)) * 16)) = o; }
            else *(GAS v4u*)(j.dst + ((size_t)(j.r0 + n) * j.K + j.k0 + 8 * c) * 2) = o; } }
    LDS_WAIT(); asm volatile("" ::: "memory");
}
__device__ __forceinline__ void cvt_job(CvtJob& j, const float* W, int K, int N, void* WT, int kind, int f8, float scale, int item, const float* gk = nullptr) {
    j.gk = gk; j.gkmax = 1 << 30; j.frag = 0;
    const int nblk = N / 64, kb = item / nblk, nb = item % nblk, k0 = 64 * kb, n0 = 64 * nb;
    j.src = W + (size_t)k0 * N + n0; j.dst = (unsigned char*)WT; j.N = N; j.K = K; j.k0 = k0; j.f8 = f8; j.scale = scale;
    j.r0 = (kind == 0) ? n0 : (256 * (n0 / 128) + (n0 % 128) + (kind == 2 ? 128 : 0));
}
__device__ __forceinline__ void norm_rows(Frame& F, const float* X, const float* gain, bf16* XN) {
    PHASE_IDS();
    const int gw = F.vcu * NWAVES + ph_wave, NGW = F.G * NWAVES;
    f32x4 g[4];
#pragma unroll
    for (int j = 0; j < 4; ++j) g[j] = ((const GAS f32x4*)gain)[ph_lane + 64 * j];
    for (int m = gw; m < M; m += 2 * NGW) {
        const int m2 = (m + NGW < M) ? m + NGW : m;
        const GAS f32x4* xa = (const GAS f32x4*)(X + (size_t)m * D) + ph_lane; const GAS f32x4* xb = (const GAS f32x4*)(X + (size_t)m2 * D) + ph_lane;
        f32x4 v[4], u[4]; float s = 0.f, t = 0.f;
#pragma unroll
        for (int j = 0; j < 4; ++j) { v[j] = xa[64 * j]; u[j] = xb[64 * j]; }
#pragma unroll
        for (int j = 0; j < 4; ++j) { s += (v[j].x * v[j].x + v[j].y * v[j].y) + (v[j].z * v[j].z + v[j].w * v[j].w); t += (u[j].x * u[j].x + u[j].y * u[j].y) + (u[j].z * u[j].z + u[j].w * u[j].w); }
        const float r = 1.f / sqrtf(wave_sum(s) * (1.f / D) + EPS), r2 = 1.f / sqrtf(wave_sum(t) * (1.f / D) + EPS);
        GAS v2u* oa = (GAS v2u*)(XN + (size_t)m * D) + ph_lane; GAS v2u* ob = (GAS v2u*)(XN + (size_t)m2 * D) + ph_lane;
#pragma unroll
        for (int j = 0; j < 4; ++j) { const f32x4 h = v[j] * r * g[j]; v2u w; w.x = cvtpk(h.x, h.y); w.y = cvtpk(h.z, h.w); oa[64 * j] = w; }
        if (m2 != m) {
#pragma unroll
            for (int j = 0; j < 4; ++j) { const f32x4 h = u[j] * r2 * g[j]; v2u w; w.x = cvtpk(h.x, h.y); w.y = cvtpk(h.z, h.w); ob[64 * j] = w; } }
    }
}
constexpr int CI_IN = (D / 64) * (DIN / 64), CI_OUT = (D / 64) * (D / 64), CI_G = (D / 64) * (DFF / 64), CI_D = (DFF / 64) * (D / 64), CI_E = (D / 64) * (DFE / 64), CI_P = 4;
constexpr int DEFER_PER_WAVE = 34, DEFER_TAIL = 4, DEFER_MOE = 38;
constexpr int CN_SMALL = 2 * CI_IN + 2 * CI_OUT + 2 * CI_G + CI_D + 8 * CI_P, CN_ITEMS = CN_SMALL + 24 * CI_E;
__device__ __forceinline__ void cvt_decode(CvtJob& j, const Args& args, unsigned char* ws, int it) {
    int r = it;
    if (r >= CN_SMALL) { r -= CN_SMALL; const int mat = r / CI_E, e = mat < 2 * NE ? mat / 2 : mat - 2 * NE, w = mat < 2 * NE ? mat % 2 : 2; r -= mat * CI_E;
        if (w == 0) cvt_job(j, args.in[12] + (size_t)e * D * DFE, D, DFE, ws + WS_WGUE + e * SZ_WGUE, 1, 1, SW1_8, r);
        else if (w == 1) cvt_job(j, args.in[13] + (size_t)e * D * DFE, D, DFE, ws + WS_WGUE + e * SZ_WGUE, 2, 1, SW1_8, r);
        else cvt_job(j, args.in[14] + (size_t)e * DFE * D, DFE, D, ws + WS_WDE + e * SZ_WDE, 0, 1, SW2_8, r);
        return; }
    if (r < 2 * CI_IN) { const int l = r / CI_IN; cvt_job(j, args.in[2] + (size_t)l * D * DIN, D, DIN, ws + WS_WIN + l * SZ_WIN, 0, 0, 1.f, r % CI_IN, l == 1 ? args.in[1] + D : nullptr); return; } r -= 2 * CI_IN;
    if (r < 2 * CI_OUT) { const int l = r / CI_OUT; cvt_job(j, args.in[6] + (size_t)l * D * D, D, D, ws + WS_WOUT + l * SZ_WOUT, 0, 0, 1.f, r % CI_OUT, args.in[5] + l * DATT);
        j.k0 = (j.k0 + DPOOL) & (D - 1); j.gkmax = DATT; return; } r -= 2 * CI_OUT;
    if (r < CI_G) { cvt_job(j, args.in[8], D, DFF, ws + WS_WGU, 1, 0, 1.f, r, args.in[7]); return; } r -= CI_G;
    if (r < CI_G) { cvt_job(j, args.in[9], D, DFF, ws + WS_WGU, 2, 0, 1.f, r, args.in[7]); return; } r -= CI_G;
    if (r < CI_D) { cvt_job(j, args.in[10], DFF, D, ws + WS_WD, 0, 1, SW2_8, r); return; } r -= CI_D;
    { const int mat = r / CI_P; cvt_job(j, args.in[3] + (size_t)mat * PGRP * PGRP, PGRP, PGRP, ws + WS_WPOOL + (size_t)mat * PGRP * PGRP * 2, 0, 0, 1.f, r % CI_P); j.frag = 1; }
}
__device__ __forceinline__ void cvt_range(Frame& F, const Args& args, int it0, int end, int stride) {
    PHASE_IDS();
    LAS float* scr = (LAS float*)(F.lds + RING_OFF) + ph_wave * (64 * 65 + 32);
    int it = it0;
    if (it < end) {
        CvtJob cur, nxt; f32x4 va[16], vb[16];
        cvt_decode(cur, args, args.ws, it); cvt_load(cur, va, ph_lane);
        for (;;) {
            const int ni = it + stride; const bool has = ni < end;
            if (has) { cvt_decode(nxt, args, args.ws, ni); cvt_load(nxt, vb, ph_lane); }
            __builtin_amdgcn_sched_barrier(0);
            cvt_store(cur, va, scr, ph_lane);
            if (!has) break;
            cur = nxt; it = ni;
#pragma unroll
            for (int i = 0; i < 16; ++i) va[i] = vb[i];
        }
    }
}
constexpr int GU_G = 208, CN_DEFER = (256 - GU_G) * NWAVES * DEFER_PER_WAVE;
constexpr int GU_UNITS = (M / 256) * (2 * DFF / 256), GU_TAIL0 = GU_UNITS - (GU_UNITS / GU_G) * GU_G, GU_TAILW = GU_G - GU_TAIL0, CN_DEFER2 = GU_TAILW * NWAVES * DEFER_TAIL;
constexpr int MG_G = 240, CN_DEFER3 = (256 - MG_G) * NWAVES * DEFER_MOE;
static_assert(CN_DEFER + CN_DEFER2 + CN_DEFER3 <= 24 * CI_E, "only expert-weight tiles are deferred (the other weights are needed before the dense gate/up phase)");
static_assert(CN_DEFER3 <= NE * CI_E, "the tiles left to the expert gate/up phase must all be down-projection tiles (that phase itself reads the gate/up weights)");
__device__ __forceinline__ bool defer_on(const Frame& F) { return F.G == 256; }
__device__ __forceinline__ void p0_prologue(Frame& F, const Args& args) {
    PHASE_IDS();
    cvt_range(F, args, F.vcu * NWAVES + ph_wave, defer_on(F) ? CN_ITEMS - CN_DEFER - CN_DEFER2 - CN_DEFER3 : CN_ITEMS, F.G * NWAVES);
    norm_rows(F, args.in[0], args.in[1], (bf16*)(args.ws + WS_XN));
}

typedef float f32x16 __attribute__((ext_vector_type(16)));
__device__ __forceinline__ int crow(int r, int hi) { return (r & 3) + 8 * (r >> 2) + 4 * hi; }
#define MFMA32(a, b, c) __builtin_amdgcn_mfma_f32_32x32x16_bf16((a), (b), (c), 0, 0, 0)
__device__ __forceinline__ bf16x8 pack8(const f32x16& x, int s) {
    v4u p; p.x = cvtpk(x[8 * s + 0], x[8 * s + 1]); p.y = cvtpk(x[8 * s + 2], x[8 * s + 3]); p.z = cvtpk(x[8 * s + 4], x[8 * s + 5]); p.w = cvtpk(x[8 * s + 6], x[8 * s + 7]);
    return __builtin_bit_cast(bf16x8, p);
}
constexpr int ASTB = 136;
constexpr int AT_STATE_BYTES = 512 * ASTB, AT_STAGE_BYTES = 8192;
__device__ __forceinline__ void at_geom(int it, int w, int& dil, int& base, int& blk) { const int pass = it >> 1, idx = w + 8 * (it & 1);
    dil = pass == 0 ? 1 : (pass == 1 ? 4 : 16); base = pass == 0 ? 0 : (pass == 1 ? (idx >> 2) : idx); blk = pass == 0 ? idx : (pass == 1 ? (idx & 3) : 0); }
__device__ __forceinline__ void attn_mfma(Frame& F, const bf16* PROJ, bf16* Y, float* SSO) {
    PHASE_IDS();
    LAS unsigned char* S = F.lds;
    const int lane = ph_lane, q = lane & 31, hi = lane >> 5, w = ph_wave;
    LAS unsigned char* stg = F.lds + AT_STATE_BYTES + w * AT_STAGE_BYTES;
    const int srow = lane >> 3, sch = lane & 7;
    LAS unsigned char* stw = stg + srow * 128 + sch * 16;
    const int lch = sch ^ srow;
    const int tq_ = (lane >> 2) & 3, tp_ = lane & 3, tg_ = (lane >> 4) & 1, kk_ = 4 * hi + tq_;
    LAS unsigned char* const vtr0 = stg + 4096 + kk_ * 128 + (((2 * tg_ + (tp_ >> 1)) ^ kk_) * 16) + 8 * (tp_ & 1);
    for (int item = F.vcu; item < BATCH * NH * 8; item += F.G) {
        const int sb = item & 7, h = (item >> 3) & 7, b = item >> 6;
        const char* Pq = (const char*)PROJ + (size_t)b * SEQ * (PPITCH * 2) + (size_t)(DPOOL + h * HD) * 2;
        const char* Pk = Pq + DATT * 2 + lch * 16;
#define AT_GEOM(it_, dil_, base_, blk_) int dil_, base_, blk_; at_geom((it_), w, dil_, base_, blk_)
#define KB_AT(kb_, blk_, tt_) int kb_; { const int r_ = (blk_) % 5 + (tt_); kb_ = 4 - (r_ >= 5 ? r_ - 5 : r_); }
#define ROW_OFF(ko_, itx, ttx) unsigned ko_[4]; { AT_GEOM(itx, dl_, bs_, bk_); KB_AT(kbx_, bk_, ttx) const int jb_ = (512 * sb) / dl_ + 32 * bk_ - 128 + 32 * kbx_ + srow; \
        _Pragma("unroll") for (int i = 0; i < 4; ++i) { int j_ = jb_ + 8 * i; j_ = j_ < 0 ? 0 : j_; ko_[i] = (unsigned)(bs_ + dl_ * j_) * (unsigned)(PPITCH * 2); } }
#define K_LOAD(K_, itx, kbx) do { ROW_OFF(ko_, itx, kbx) _Pragma("unroll") for (int i = 0; i < 4; ++i) K_[i] = *(const GAS bf16x8*)(Pk + ko_[i]); } while (0)
#define V_LOAD(V_, itx, kbx) do { ROW_OFF(ko_, itx, kbx) _Pragma("unroll") for (int i = 0; i < 4; ++i) V_[i] = *(const GAS bf16x8*)(Pk + ko_[i] + DATT * 2); } while (0)
#define Q_LOAD(Q_, itx) do { AT_GEOM(itx, dl_, bs_, bk_); \
        _Pragma("unroll") for (int i = 0; i < 4; ++i) { const int lp_ = bs_ + dl_ * (32 * bk_ + 8 * i + srow); Q_[i] = *(const GAS bf16x8*)(Pq + (size_t)(512 * sb + lp_) * (PPITCH * 2) + lch * 16); } \
        _Pragma("unroll") for (int i = 0; i < 4; ++i) *(LAS bf16x8*)(stw + 1024 * i) = Q_[i]; \
        _Pragma("unroll") for (int d0 = 0; d0 < 4; ++d0) { const int pc = ((2 * d0 + hi) ^ (q & 7)) * 16; Q_[d0] = *(const LAS bf16x8*)(stg + q * 128 + pc); } } while (0)
        bf16x8 rk[4], rk2[4], rv[4];
        K_LOAD(rk, 0, 0); V_LOAD(rv, 0, 0); K_LOAD(rk2, 0, 1);
        for (int it = 0; it < 6; ++it) {
            AT_GEOM(it, dil, base, blk);
            const int pass = it >> 1;
            const int lp = base + dil * (32 * blk + q);
            const int i0 = (512 * sb) / dil + 32 * blk;
            LAS unsigned char* sr = S + lp * ASTB;
            f32x16 o0, o1; float m, l;
            if (pass == 0) {
#pragma unroll
                for (int i = 0; i < 16; ++i) { o0[i] = 0.f; o1[i] = 0.f; }
                m = -1e30f; l = 0.f;
            } else {
#pragma unroll
                for (int g = 0; g < 4; ++g) { const v2u a = *(const LAS v2u*)(sr + (8 * g + 4 * hi) * 2), c4 = *(const LAS v2u*)(sr + (32 + 8 * g + 4 * hi) * 2);
                    o0[4 * g] = bflo(a.x); o0[4 * g + 1] = bfhi(a.x); o0[4 * g + 2] = bflo(a.y); o0[4 * g + 3] = bfhi(a.y); o1[4 * g] = bflo(c4.x); o1[4 * g + 1] = bfhi(c4.x); o1[4 * g + 2] = bflo(c4.y); o1[4 * g + 3] = bfhi(c4.y); }
                m = *(const LAS float*)(sr + 128); l = hi ? 0.f : *(const LAS float*)(sr + 132);
            }
            bf16x8 qf[4];
            Q_LOAD(qf, it);
#define K_EVENT(e_) { _Pragma("unroll") for (int i = 0; i < 4; ++i) *(LAS bf16x8*)(stw + 1024 * i) = rk[i]; \
                __builtin_amdgcn_sched_barrier(0); \
                _Pragma("unroll") for (int i = 0; i < 4; ++i) rk[i] = rk2[i]; \
                { const int nit = it + ((e_) + 2) / 5, ntt = ((e_) + 2) % 5; if (nit < 6) K_LOAD(rk2, nit, ntt); } \
                __builtin_amdgcn_sched_barrier(0); }
#define QK_TO(S_) { bf16x8 kc[4]; \
                _Pragma("unroll") for (int d0 = 0; d0 < 4; ++d0) { const int pc = ((2 * d0 + hi) ^ (q & 7)) * 16; kc[d0] = *(const LAS bf16x8*)(stg + q * 128 + pc); } \
                _Pragma("unroll") for (int i = 0; i < 16; ++i) S_[i] = 0.f; \
                _Pragma("unroll") for (int d0 = 0; d0 < 4; ++d0) S_ = MFMA32(kc[d0], qf[d0], S_); }
            f32x16 sbuf[2];
            K_EVENT(0) { KB_AT(kb0_, blk, 0) if (i0 - 128 + 32 * kb0_ + 31 >= 0) QK_TO(sbuf[0]) }
#pragma unroll
            for (int kbi = 0; kbi < 5; ++kbi) {
                KB_AT(kb, blk, kbi)
                const int jb = i0 - 128 + 32 * kb;
                if (kbi < 4) { K_EVENT(kbi + 1) KB_AT(kbn_, blk, kbi + 1) if (i0 - 128 + 32 * kbn_ + 31 >= 0) QK_TO(sbuf[(kbi + 1) & 1]) }
                if (jb + 31 >= 0) {
                    f32x16& s = sbuf[kbi & 1];
                    if (kb == 0 || kb == 4 || jb < 0) {
                        int lo = kb == 0 ? q : 0; lo = lo > -jb ? lo : -jb; const int hb = kb == 4 ? q : 31;
#pragma unroll
                        for (int i = 0; i < 16; ++i) { const int c = crow(i, hi); s[i] = (c >= lo && c <= hb) ? s[i] : -3.0e38f; }
                    }
                    float bm = s[0];
#pragma unroll
                    for (int i = 1; i < 16; ++i) bm = fmaxf(bm, s[i]);
                    bm = fmaxf(bm, __shfl_xor(bm, 32));
                    const float mn = fmaxf(m, bm), sc = __builtin_amdgcn_exp2f(m - mn);
                    m = mn;
                    float ps = 0.f;
#pragma unroll
                    for (int i = 0; i < 16; ++i) { s[i] = __builtin_amdgcn_exp2f(s[i] - mn); ps += s[i]; }
                    l = l * sc + ps;
#pragma unroll
                    for (int i = 0; i < 16; ++i) { o0[i] *= sc; o1[i] *= sc; }
                    const bf16x8 pb0 = pack8(s, 0), pb1 = pack8(s, 1);
#pragma unroll
                    for (int i = 0; i < 4; ++i) *(LAS bf16x8*)(stw + 4096 + 1024 * i) = rv[i];
                    __builtin_amdgcn_sched_barrier(0);
                    { const int nit = it + (kbi + 1) / 5, ntt = (kbi + 1) % 5; if (nit < 6) V_LOAD(rv, nit, ntt); }
                    __builtin_amdgcn_sched_barrier(0);
                    { s16x4 va_[2][2][2];
                      asm volatile("ds_read_b64_tr_b16 %0, %8\n\tds_read_b64_tr_b16 %1, %8 offset:1024\n\tds_read_b64_tr_b16 %2, %8 offset:2048\n\tds_read_b64_tr_b16 %3, %8 offset:3072\n\t"
                                   "ds_read_b64_tr_b16 %4, %9\n\tds_read_b64_tr_b16 %5, %9 offset:1024\n\tds_read_b64_tr_b16 %6, %9 offset:2048\n\tds_read_b64_tr_b16 %7, %9 offset:3072\n\t"
                                   "s_waitcnt lgkmcnt(0)"
                                   : "=&v"(va_[0][0][0]), "=&v"(va_[0][0][1]), "=&v"(va_[0][1][0]), "=&v"(va_[0][1][1]), "=&v"(va_[1][0][0]), "=&v"(va_[1][0][1]), "=&v"(va_[1][1][0]), "=&v"(va_[1][1][1])
                                   : "v"(vtr0), "v"(vtr0 + 64 - 2 * (((2 * tg_ + (tp_ >> 1)) ^ kk_) & 4) * 16) : "memory");
#define TR_PK(X_) (bf16x8){X_[0][0], X_[0][1], X_[0][2], X_[0][3], X_[1][0], X_[1][1], X_[1][2], X_[1][3]}
                      o0 = MFMA32(TR_PK(va_[0][0]), pb0, o0); o1 = MFMA32(TR_PK(va_[1][0]), pb0, o1);
                      o0 = MFMA32(TR_PK(va_[0][1]), pb1, o0); o1 = MFMA32(TR_PK(va_[1][1]), pb1, o1);
#undef TR_PK
                    }
                } else { const int nit = it + (kbi + 1) / 5, ntt = (kbi + 1) % 5; if (nit < 6) V_LOAD(rv, nit, ntt); }
            }
            const float lt = l + __shfl_xor(l, 32);
            if (pass == 2) { const float il = 1.f / lt;
#pragma unroll
                for (int i = 0; i < 16; ++i) { o0[i] *= il; o1[i] *= il; } }
#pragma unroll
            for (int g = 0; g < 4; ++g) { v2u a, c4; a.x = cvtpk(o0[4 * g], o0[4 * g + 1]); a.y = cvtpk(o0[4 * g + 2], o0[4 * g + 3]); c4.x = cvtpk(o1[4 * g], o1[4 * g + 1]); c4.y = cvtpk(o1[4 * g + 2], o1[4 * g + 3]);
                *(LAS v2u*)(sr + (8 * g + 4 * hi) * 2) = a; *(LAS v2u*)(sr + (32 + 8 * g + 4 * hi) * 2) = c4; }
            if (hi == 0) { *(LAS float*)(sr + 128) = m; *(LAS float*)(sr + 132) = lt; }
            if (it & 1) asm volatile("s_waitcnt lgkmcnt(0)\n\ts_barrier" ::: "memory");
        }
#undef AT_GEOM
#undef K_LOAD
#undef V_LOAD
#undef ROW_OFF
#undef Q_LOAD
#undef KB_AT
#undef K_EVENT
#undef QK_TO
        { bf16* Ob = Y + (size_t)(b * SEQ + 512 * sb) * D + h * HD; float* so = SSO + (size_t)(b * SEQ + 512 * sb) * 8 + h;
          int to_ = tid_; asm volatile("" : "+v"(to_));
#pragma unroll
          for (int it = 0; it < 8; ++it) { const int row = it * 64 + (to_ >> 3), ch = to_ & 7; const LAS unsigned char* s8 = S + row * ASTB + 16 * ch;
              const v2u a = *(const LAS v2u*)s8, c4 = *(const LAS v2u*)(s8 + 8);
              v4u wv; wv.x = a.x; wv.y = a.y; wv.z = c4.x; wv.w = c4.y;
              *(GAS v4u*)(Ob + (size_t)row * D + 8 * ch) = wv;
              float sq = (bflo(a.x) * bflo(a.x) + bfhi(a.x) * bfhi(a.x)) + (bflo(a.y) * bflo(a.y) + bfhi(a.y) * bfhi(a.y)) + (bflo(c4.x) * bflo(c4.x) + bfhi(c4.x) * bfhi(c4.x)) + (bflo(c4.y) * bflo(c4.y) + bfhi(c4.y) * bfhi(c4.y));
              sq += __shfl_xor(sq, 1); sq += __shfl_xor(sq, 2); sq += __shfl_xor(sq, 4);
              if (ch == 0) so[(size_t)row * 8] = sq; } }
        asm volatile("s_waitcnt lgkmcnt(0)\n\ts_barrier" ::: "memory");
    }
}

__device__ __forceinline__ short small_int_bf16(int v) { return (short)(__float_as_uint((float)v) >> 16); }
__device__ __forceinline__ void pool_mfma(Frame& F, const bf16* PROJ, const bf16* WPT, const float* pscale, bf16* Y) {
    PHASE_IDS();
    const int lane = ph_lane, q = lane & 31, hi = lane >> 5, w = ph_wave, g = w >> 1, eh = w & 1, win = 2 << g;
    LAS float* part = (LAS float*)F.lds;
    LAS unsigned char* const T0 = F.lds + 1024 + w * 16384; LAS unsigned char* const T1 = T0 + 8192;
    const int ch0 = 128 * g + 64 * eh;
    const int srow_ = lane >> 4, sch_ = lane & 15;
    bf16x8 wf[2][8];
    { const char* wb = (const char*)WPT + (size_t)((g * 2 + eh) * 16) * 1024 + lane * 16;
#pragma unroll
      for (int eb = 0; eb < 2; ++eb)
#pragma unroll
          for (int ks = 0; ks < 8; ++ks) wf[eb][ks] = *(const GAS bf16x8*)(wb + (eb * 8 + ks) * 1024); }
    for (int run = F.vcu; run < M / 64; run += F.G) {
        const int row0 = run * 64, p0 = row0 % SEQ;
        bf16x8 ra[8], rb[8];
#define U_LOAD(R_, r_) do { const char* up_ = (const char*)PROJ + (size_t)((r_) + srow_) * (PPITCH * 2) + (size_t)(128 * g) * 2 + sch_ * 16; \
        _Pragma("unroll") for (int i = 0; i < 8; ++i) R_[i] = *(const GAS bf16x8*)(up_ + (size_t)(4 * i) * (PPITCH * 2)); } while (0)
#define U_STAGE(T_, R_) do { _Pragma("unroll") for (int i = 0; i < 8; ++i) *(LAS bf16x8*)(T_ + (srow_ + 4 * i) * 256 + ((sch_ ^ ((srow_ + 4 * i) & 15)) * 16)) = R_[i]; } while (0)
#define U_GEMM(GA_, T_) do { _Pragma("unroll") for (int eb = 0; eb < 2; ++eb) _Pragma("unroll") for (int i = 0; i < 16; ++i) GA_[eb][i] = 0.f; \
        _Pragma("unroll") for (int ks = 0; ks < 8; ++ks) { const bf16x8 uf = *(const LAS bf16x8*)(T_ + q * 256 + (((2 * ks + hi) ^ (q & 15)) * 16)); \
            _Pragma("unroll") for (int eb = 0; eb < 2; ++eb) GA_[eb] = MFMA32(uf, wf[eb][ks], GA_[eb]); } } while (0)
        if (p0 > 0) U_LOAD(ra, row0 - 32);
        U_LOAD(rb, row0);
        bf16x8 gp[2];
#pragma unroll
        for (int eb = 0; eb < 2; ++eb)
#pragma unroll
            for (int j = 0; j < 8; ++j) gp[eb][j] = 0;
        if (p0 > 0) { U_STAGE(T0, ra); }
        U_STAGE(T1, rb);
        U_LOAD(ra, row0 + 32);
        if (p0 > 0) { f32x16 ga[2]; U_GEMM(ga, T0); gp[0] = pack8(ga[0], 1); gp[1] = pack8(ga[1], 1); }
#define POOL_TILE(T_, tt) { \
            const int r0 = row0 + 32 * (tt), pp = p0 + 32 * (tt); \
            f32x16 ga[2]; U_GEMM(ga, T_); \
            const int cnt = (pp + q + 1) < win ? (pp + q + 1) : win; \
            bf16x8 pmo[2], pmp; \
            _Pragma("unroll") for (int s2 = 0; s2 < 2; ++s2) _Pragma("unroll") for (int j = 0; j < 8; ++j) { const int tp = 16 * s2 + 8 * (j >> 2) + 4 * hi + (j & 3); int v = (tp <= q && tp >= q - win + 1) ? 1 : 0; if (tp == q) v -= cnt; pmo[s2][j] = small_int_bf16(v); } \
            _Pragma("unroll") for (int j = 0; j < 8; ++j) { const int tp = 16 + 8 * (j >> 2) + 4 * hi + (j & 3); pmp[j] = (pp > 0 && tp - 32 >= q - win + 1) ? (short)0x3F80 : (short)0; } \
            f32x16 z[2]; float ss = 0.f; const float ic = 1.f / (float)cnt; \
            _Pragma("unroll") for (int eb = 0; eb < 2; ++eb) { \
                _Pragma("unroll") for (int i = 0; i < 16; ++i) z[eb][i] = 0.f; \
                const bf16x8 a0 = pack8(ga[eb], 0), a1 = pack8(ga[eb], 1); \
                z[eb] = MFMA32(a0, pmo[0], z[eb]); z[eb] = MFMA32(a1, pmo[1], z[eb]); z[eb] = MFMA32(gp[eb], pmp, z[eb]); \
                gp[eb] = a1; \
                _Pragma("unroll") for (int i = 0; i < 16; ++i) { z[eb][i] *= ic; ss += z[eb][i] * z[eb][i]; } } \
            ss += __shfl_xor(ss, 32); \
            if (hi == 0) part[w * 32 + q] = ss; \
            __syncthreads(); \
            float tot = 0.f; \
            _Pragma("unroll") for (int k = 0; k < 8; ++k) tot += part[k * 32 + q]; \
            const float ra_ = 1.f / sqrtf(tot * (1.f / DPOOL) + EPS); \
              \
            _Pragma("unroll") for (int eb = 0; eb < 2; ++eb) _Pragma("unroll") for (int gq = 0; gq < 4; ++gq) { const f32x4 p4 = *(const GAS f32x4*)(pscale + ch0 + 32 * eb + 8 * gq + 4 * hi); v2u wv; \
                wv.x = cvtpk(z[eb][4 * gq] * ra_ * p4.x, z[eb][4 * gq + 1] * ra_ * p4.y); wv.y = cvtpk(z[eb][4 * gq + 2] * ra_ * p4.z, z[eb][4 * gq + 3] * ra_ * p4.w); \
                *(LAS v2u*)(T_ + q * 128 + (((4 * eb + gq) ^ (q & 7)) * 16) + 8 * hi) = wv; } \
            _Pragma("unroll") for (int i = 0; i < 4; ++i) { const int orow = (lane >> 3) + 8 * i, oc = lane & 7; \
                const v4u ov = *(const LAS v4u*)(T_ + orow * 128 + ((oc ^ (orow & 7)) * 16)); \
                *(GAS v4u*)(Y + (size_t)(r0 + orow) * D + DATT + ch0 + 8 * oc) = ov; } \
            __syncthreads(); }
        POOL_TILE(T1, 0)
        U_STAGE(T0, ra);
        POOL_TILE(T0, 1)
#undef POOL_TILE
#undef U_GEMM
#undef U_STAGE
#undef U_LOAD
    }
}

__device__ __forceinline__ void norm_router(Frame& F, const bf16* X, const float* gain, const float* wrt, unsigned char* XS, int* tokinfo, unsigned* gcnt) {
    PHASE_IDS();
    LAS float* wl = (LAS float*)(F.lds + RING_OFF);
    LAS int* lcnt = (LAS int*)(F.lds + RING_OFF + 40960); LAS int* lbase = lcnt + 8; LAS int* stash = lcnt + 16;
    LAS unsigned char* rows8 = F.lds + RING_OFF + 49152;
    const int lane = ph_lane;
    for (int k = tid_; k < D; k += NWAVES * 64) { const f32x4 a = *(const GAS f32x4*)(wrt + 8 * k), b = *(const GAS f32x4*)(wrt + 8 * k + 4);
        *(LAS f32x4*)(wl + 8 * k + 4 * (k >> 2)) = a; *(LAS f32x4*)(wl + 8 * k + 4 * (k >> 2) + 4) = b; }
    f32x4 g[4];
#pragma unroll
    for (int j = 0; j < 4; ++j) g[j] = ((const GAS f32x4*)gain)[lane + 64 * j];
    for (int ch = F.vcu; ch < M / 64; ch += F.G) {
        if (tid_ < 8) lcnt[tid_] = 0;
        __syncthreads();
        for (int rb4 = 0; rb4 < 8; rb4 += 4) {
            f32x4 vv[4][4];
#pragma unroll
            for (int r4 = 0; r4 < 4; ++r4) { const GAS v2u* xr = (const GAS v2u*)(X + (size_t)(ch * 64 + ph_wave * 8 + rb4 + r4) * D) + lane;
#pragma unroll
                for (int j = 0; j < 4; ++j) { const v2u w = xr[64 * j]; vv[r4][j] = (f32x4){bflo(w.x), bfhi(w.x), bflo(w.y), bfhi(w.y)}; } }
#pragma unroll
            for (int r4 = 0; r4 < 4; ++r4) {
                const int lr = ph_wave * 8 + rb4 + r4;
                float s = 0.f;
#pragma unroll
                for (int j = 0; j < 4; ++j) { const f32x4 x = vv[r4][j]; s += (x.x * x.x + x.y * x.y) + (x.z * x.z + x.w * x.w); }
                const float r = 1.f / sqrtf(wave_sum(s) * (1.f / D) + EPS);
                LAS unsigned* o4 = (LAS unsigned*)(rows8 + lr * 1024) + lane;
                float lg[8];
#pragma unroll
                for (int e = 0; e < 8; ++e) lg[e] = 0.f;
#pragma unroll
                for (int j = 0; j < 4; ++j) { const f32x4 h = vv[r4][j] * r * g[j]; o4[64 * j] = cvt4_fp8(h.x * SX8, h.y * SX8, h.z * SX8, h.w * SX8);
#pragma unroll
                    for (int i = 0; i < 4; ++i) { const int k = 4 * lane + 256 * j + i; const f32x4 a = *(const LAS f32x4*)(wl + 8 * k + 4 * (k >> 2)), b = *(const LAS f32x4*)(wl + 8 * k + 4 * (k >> 2) + 4);
                        const float hv = h[i]; lg[0] += hv * a.x; lg[1] += hv * a.y; lg[2] += hv * a.z; lg[3] += hv * a.w; lg[4] += hv * b.x; lg[5] += hv * b.y; lg[6] += hv * b.z; lg[7] += hv * b.w; } }
                float a4[4];
#pragma unroll
                for (int j = 0; j < 4; ++j) { const float keep = (lane & 1) ? lg[2 * j + 1] : lg[2 * j], send = (lane & 1) ? lg[2 * j] : lg[2 * j + 1]; a4[j] = keep + __shfl_xor(send, 1); }
                float a2[2];
#pragma unroll
                for (int j = 0; j < 2; ++j) { const float keep = (lane & 2) ? a4[2 * j + 1] : a4[2 * j], send = (lane & 2) ? a4[2 * j] : a4[2 * j + 1]; a2[j] = keep + __shfl_xor(send, 2); }
                float a1; { const float keep = (lane & 4) ? a2[1] : a2[0], send = (lane & 4) ? a2[0] : a2[1]; a1 = keep + __shfl_xor(send, 4); }
                a1 += __shfl_xor(a1, 8); a1 += __shfl_xor(a1, 16); a1 += __shfl_xor(a1, 32);
#pragma unroll
                for (int e = 0; e < 8; ++e) lg[e] = __shfl(a1, e);
                int e0 = 0; float v0 = lg[0];
#pragma unroll
                for (int e = 1; e < 8; ++e) if (lg[e] > v0) { v0 = lg[e]; e0 = e; }
                int e1 = -1; float v1 = -3.0e38f;
#pragma unroll
                for (int e = 0; e < 8; ++e) if (e != e0 && lg[e] > v1) { v1 = lg[e]; e1 = e; }
                const float ex = expf(v1 - v0), g0 = 1.f / (1.f + ex), g1 = ex * g0;
                if (lane == 0) { const int p0 = __hip_atomic_fetch_add(lcnt + e0, 1, __ATOMIC_RELAXED, __HIP_MEMORY_SCOPE_WORKGROUP), p1 = __hip_atomic_fetch_add(lcnt + e1, 1, __ATOMIC_RELAXED, __HIP_MEMORY_SCOPE_WORKGROUP);
                    stash[lr * 6 + 0] = e0; stash[lr * 6 + 1] = e1; stash[lr * 6 + 2] = p0; stash[lr * 6 + 3] = p1; stash[lr * 6 + 4] = __float_as_int(g0); stash[lr * 6 + 5] = __float_as_int(g1); }
            }
        }
        __syncthreads();
        if (tid_ < 8) lbase[tid_] = (int)__hip_atomic_fetch_add(gcnt + tid_, (unsigned)lcnt[tid_], RLX_AGENT);
        __syncthreads();
        for (int rr = 0; rr < 8; ++rr) {
            const int lr = ph_wave * 8 + rr, m = ch * 64 + lr;
            const int e0 = stash[lr * 6], e1 = stash[lr * 6 + 1]; const int p0 = lbase[e0] + stash[lr * 6 + 2], p1 = lbase[e1] + stash[lr * 6 + 3];
            const v4u rowv = *(const LAS v4u*)(rows8 + lr * 1024 + lane * 16);
            *(GAS v4u*)(XS + ((size_t)e0 * M + p0) * D + lane * 16) = rowv;
            *(GAS v4u*)(XS + ((size_t)e1 * M + p1) * D + lane * 16) = rowv;
            if (lane == 0) { int* ti = tokinfo + (size_t)m * 8; ti[0] = e0; ti[1] = e1; ti[2] = p0; ti[3] = p1; ti[4] = stash[lr * 6 + 4]; ti[5] = stash[lr * 6 + 5]; }
        }
        __syncthreads();
    }
}

__device__ __forceinline__ void final_phase(Frame& F, const bf16* X, float* OUT, const bf16* YM, const int* tokinfo, const unsigned* gcnt, const float* gain, const int* ovf, const bf16* SLAB) {
    const int tid_ = F.wave * 64 + lane_id(), ph_lane = tid_ & 63, ph_wave = F.wave; (void)ph_lane; (void)ph_wave;
    const int gw = F.vcu * NWAVES + ph_wave, NGW = F.G * NWAVES, lane = ph_lane;
    int ts[NE + 1]; ts[0] = 0;
#pragma unroll
    for (int e = 0; e < NE; ++e) { const int c = (int)__builtin_amdgcn_readfirstlane(gcnt[e]); ts[e + 1] = ts[e] + (c + 255) / 256; }
    f32x4 g[4];
#pragma unroll
    for (int j = 0; j < 4; ++j) g[j] = ((const GAS f32x4*)gain)[lane + 64 * j];
    int ovS = 1; { const int U = ts[NE] * (D / 256), Rr = U - (U / F.G) * F.G; ovS = (Rr > 0 && Rr * 7 <= F.G) ? 7 : ((Rr > 0 && Rr * 2 <= F.G) ? 2 : 1); }
    for (int mb = gw; mb < M; mb += 4 * NGW) {
        int mr = mb + (lane & 3) * NGW; mr = mr < M ? mr : mb;
        const v4u t0 = *(const GAS v4u*)(tokinfo + (size_t)mr * 8); const v2u t1 = *(const GAS v2u*)(tokinfo + (size_t)mr * 8 + 4);
        v2u xv[4][4]; f32x4 v[4][4]; v2u ya[4][4], yb[4][4]; float g0[4], g1[4]; int rr0[4], rr1[4]; v4u oa[4], ob[4];
#pragma unroll
        for (int r = 0; r < 4; ++r) {
            const int m = (mb + r * NGW < M) ? mb + r * NGW : mb;
            const int e0 = __builtin_amdgcn_readlane((int)t0.x, r), e1 = __builtin_amdgcn_readlane((int)t0.y, r), p0 = __builtin_amdgcn_readlane((int)t0.z, r), p1 = __builtin_amdgcn_readlane((int)t0.w, r);
            g0[r] = __int_as_float(__builtin_amdgcn_readlane((int)t1.x, r)); g1[r] = __int_as_float(__builtin_amdgcn_readlane((int)t1.y, r));
            int t0s = 0, t1s = 0;
#pragma unroll
            for (int e = 0; e < NE; ++e) { t0s = (e0 == e) ? ts[e] : t0s; t1s = (e1 == e) ? ts[e] : t1s; }
            const size_t r0 = (size_t)t0s * 256 + p0, r1 = (size_t)t1s * 256 + p1; rr0[r] = (int)r0; rr1[r] = (int)r1; oa[r] = *(const GAS v4u*)(ovf + (r0 >> 8) * 4); ob[r] = *(const GAS v4u*)(ovf + (r1 >> 8) * 4);
            const GAS v2u* xr = (const GAS v2u*)(X + (size_t)m * D) + lane;
            const GAS v2u* y0 = (const GAS v2u*)(YM + r0 * D) + lane; const GAS v2u* y1 = (const GAS v2u*)(YM + r1 * D) + lane;
#pragma unroll
            for (int j = 0; j < 4; ++j) { xv[r][j] = xr[64 * j]; ya[r][j] = y0[64 * j]; yb[r][j] = y1[64 * j]; }
        }
#pragma unroll
        for (int r = 0; r < 4; ++r) {
            const int m = mb + r * NGW;
            if (m < M) {
                float s = 0.f;
                const unsigned anyov = (ovS > 1) ? (unsigned)__builtin_amdgcn_readfirstlane((int)(oa[r].x | oa[r].y | oa[r].z | oa[r].w | ob[r].x | ob[r].y | ob[r].z | ob[r].w)) : 0u;
                if (anyov == 0u) {
#pragma unroll
                    for (int j = 0; j < 4; ++j) { const v2u a = ya[r][j], b2 = yb[r][j]; const v2u xw_ = xv[r][j]; f32x4 x = (f32x4){bflo(xw_.x), bfhi(xw_.x), bflo(xw_.y), bfhi(xw_.y)};
                        x.x += g0[r] * bflo(a.x) + g1[r] * bflo(b2.x); x.y += g0[r] * bfhi(a.x) + g1[r] * bfhi(b2.x); x.z += g0[r] * bflo(a.y) + g1[r] * bflo(b2.y); x.w += g0[r] * bfhi(a.y) + g1[r] * bfhi(b2.y);
                        v[r][j] = x; s += (x.x * x.x + x.y * x.y) + (x.z * x.z + x.w * x.w); }
                } else {
#pragma unroll
                    for (int j = 0; j < 4; ++j) { const v2u a = ya[r][j], b2 = yb[r][j]; const v2u xw_ = xv[r][j]; f32x4 x = (f32x4){bflo(xw_.x), bfhi(xw_.x), bflo(xw_.y), bfhi(xw_.y)};
                        f32x4 fa = (f32x4){bflo(a.x), bfhi(a.x), bflo(a.y), bfhi(a.y)}, fb = (f32x4){bflo(b2.x), bfhi(b2.x), bflo(b2.y), bfhi(b2.y)};
                        const int ea = __builtin_amdgcn_readfirstlane((int)oa[r][j]), eb = __builtin_amdgcn_readfirstlane((int)ob[r][j]);
                        if (ea) { fa = (f32x4){0.f, 0.f, 0.f, 0.f}; for (int sl = 0; sl < ovS; ++sl) { const v2u w = *((const GAS v2u*)(SLAB + ((size_t)((ea - 1) * ovS + sl) * 256 + (rr0[r] & 255)) * 256) + lane); fa += (f32x4){bflo(w.x), bfhi(w.x), bflo(w.y), bfhi(w.y)}; } }
                        if (eb) { fb = (f32x4){0.f, 0.f, 0.f, 0.f}; for (int sl = 0; sl < ovS; ++sl) { const v2u w = *((const GAS v2u*)(SLAB + ((size_t)((eb - 1) * ovS + sl) * 256 + (rr1[r] & 255)) * 256) + lane); fb += (f32x4){bflo(w.x), bfhi(w.x), bflo(w.y), bfhi(w.y)}; } }
                        x = x + fa * g0[r] + fb * g1[r];
                        v[r][j] = x; s += (x.x * x.x + x.y * x.y) + (x.z * x.z + x.w * x.w); }
                }
                const float rr = 1.f / sqrtf(wave_sum(s) * (1.f / D) + EPS);
                GAS f32x4* xw = (GAS f32x4*)(OUT + (size_t)m * D) + lane;
#pragma unroll
                for (int j = 0; j < 4; ++j) __builtin_nontemporal_store(v[r][j] * rr * g[j], xw + 64 * j);
            }
        }
    }
}

constexpr int NPH = 13;
__global__ void __launch_bounds__(NWAVES * 64, 2) trunk_fwd(Args args) {
    extern __shared__ __attribute__((aligned(16))) unsigned char lds[];
    Frame F;
    F.lds = (LAS unsigned char*)lds;
    F.MISC = (volatile LAS unsigned*)(F.lds + MISC_OFF);
    F.wave = __builtin_amdgcn_readfirstlane((int)threadIdx.x >> 6);
    F.G = gridDim.x; { const int bx = blockIdx.x; F.vcu = (F.G % 8 == 0) ? (bx % 8) * (F.G / 8) + bx / 8 : bx; }
    F.ctl = (gu32*)(args.ws + WS_CTL);
    for (int u = threadIdx.x; u < (LDS_BYTES - LDSCTL_OFF) / 4; u += NWAVES * 64) ((LAS unsigned*)(F.lds + LDSCTL_OFF))[u] = 0u;
    __syncthreads();
#if MK_ONE_LAUNCH
    (void)xcd_barrier_post((unsigned*)(F.ctl + CW_BAR), F.MISC + 8);
#define GRID_BAR() do { XcdBarrier bar_; bar_.bar = (unsigned*)(F.ctl + CW_BAR); bar_.x = xb_xcc_id(); bar_.st = F.MISC + 8; xcd_barrier(bar_, F.wave == 0 && lane_id() == 0); } while (0)
#else
#define GRID_BAR() do { } while (0)
#endif
    const int lo = args.ph_lo, hi = args.ph_hi; (void)lo; (void)hi;
#if MK_ONE_LAUNCH
#define IN(k) true
#else
#define IN(k) (lo <= (k) && (k) < hi)
#endif
#define SEAM(k) do { if (IN(k) && IN((k) + 1)) GRID_BAR(); } while (0)
#define PH_WS() unsigned char* ws = args.ws; asm volatile("" : "+s"(ws))
#define XN ((bf16*)(ws + WS_XN))
#define AR (ws + WS_ARENA)
#define PROJ ((bf16*)(AR + AR_PROJ))
#define OB ((bf16*)(AR + AR_O))
#define YB ((bf16*)(AR + AR_Y))
#define HB ((bf16*)(AR + AR_H))
#define HM ((bf16*)(AR + AR_HM))
#define YM ((bf16*)(AR + AR_YM))
#define tokinfo ((int*)(ws + WS_ROUTE))
#define gcnt ((unsigned*)(F.ctl + CW_ECNT))
#define RTAB ((LAS float*)(F.lds + RING_BYTES + 1024))
    const int c = (int)blockIdx.x;
    LAS unsigned char* ring = F.lds + RING_OFF;

#define PH(k, ...) if (IN(k)) { { PH_WS(); __VA_ARGS__ } if ((PROBE_MASK >> (k)) & 1u) { GRID_BAR(); PH_WS(); __VA_ARGS__ } } SEAM(k);
#define PHL(k, ...) if (IN(k)) { PH_WS(); __VA_ARGS__ }
    PH(0, (void)ws; p0_prologue(F, args);)

#define LAYER_MIX(P, l, EPI_, BASE_, SSW_, X8_) \
    PH((P) + 0, pg8::ProbDense pr{(const char*)XN, (const char*)(ws + WS_WIN + (size_t)(l) * SZ_WIN), D, M / 256, DIN / 256, F.G, c}; \
        pg8::EpiBf16 ep{PROJ, PPITCH, 2, 4, C2, (l) == 0 ? nullptr : (const float*)(ws + WS_SS), RTAB}; pg8::gemm_phase<false>(ring, pr, ep);) \
    PH((P) + 1, attn_mfma(F, PROJ, YB, (float*)(ws + WS_SSO)); \
        pool_mfma(F, PROJ, (const bf16*)(ws + WS_WPOOL) + (size_t)(l) * 4 * PGRP * PGRP, args.in[4] + (l) * DPOOL, YB);) \
    PH((P) + 2, typename pg8::identity_t<void EPI_>::type ep{BASE_, XN, D, SSW_, X8_}; \
        for (int ui_ = 0; ui_ * F.G + c < (M / 256) * (D / 256); ++ui_) { \
            pg8::ProbDense pr{(const char*)YB, (const char*)(ws + WS_WOUT + (size_t)(l) * SZ_WOUT), D, M / 256, D / 256, F.G, c, ui_, 1, (const float*)(ws + WS_SSO), RTAB}; \
            pg8::gemm_phase<false, true>(ring, pr, ep); })

    LAYER_MIX(1, 0, (pg8::EpiRes<true>), (const void*)args.in[0], (float*)(ws + WS_SS), (unsigned char*)nullptr)
    PH(4, if (defer_on(F) && c >= GU_G) { cvt_range(F, args, CN_ITEMS - CN_DEFER3 - CN_DEFER + (c - GU_G) * NWAVES + F.wave, CN_ITEMS - CN_DEFER3, (256 - GU_G) * NWAVES); } else {
        pg8::ProbDense pr{(const char*)XN, (const char*)(ws + WS_WGU), D, M / 256, 2 * DFF / 256, defer_on(F) ? GU_G : F.G, c};
        pg8::EpiSwiGLU8 ep{(unsigned char*)HB, DFF, 1.f, (const float*)(ws + WS_SS), RTAB}; pg8::gemm_phase<false>(ring, pr, ep);
        if (defer_on(F) && c >= GU_TAIL0) { __syncthreads(); cvt_range(F, args, CN_ITEMS - CN_DEFER3 - CN_DEFER - CN_DEFER2 + (c - GU_TAIL0) * NWAVES + F.wave, CN_ITEMS - CN_DEFER3 - CN_DEFER, GU_TAILW * NWAVES); } })
    PH(5, pg8::ProbDense pr{(const char*)HB, (const char*)(ws + WS_WD), DFF / 2, M / 256, D / 256, F.G, c}; pr.ablk = true;
        pg8::EpiRes<false, false, true> ep{(const void*)XN, XN, D, (float*)(ws + WS_SS), nullptr, 1.f / (SH8 * SW2_8)}; pg8::gemm_phase<true>(ring, pr, ep);)
    LAYER_MIX(6, 1, (pg8::EpiRes<false>), (const void*)XN, (float*)nullptr, (unsigned char*)nullptr)
    PH(9, norm_router(F, XN, args.in[7] + D, args.in[11], AR + AR_XS, tokinfo, gcnt);)
#define MOE_SETUP(PR) { LAS int* tab_ = (LAS int*)(F.lds + LDSCTL_OFF + 512); __syncthreads(); if (threadIdx.x == 0) { int acc_ = 0; tab_[0] = 0; for (int e = 0; e < NE; ++e) { const int ce = (int)__hip_atomic_load(gcnt + e, RLX_AGENT); tab_[NE + 1 + e] = ce; acc_ += (ce + 255) / 256; tab_[e + 1] = acc_; } } __syncthreads(); \
        PR.tab = tab_; PR.nT = __builtin_amdgcn_readfirstlane(tab_[NE]); }
    PH(10, if (defer_on(F) && c >= MG_G) { cvt_range(F, args, CN_ITEMS - CN_DEFER3 + (c - MG_G) * NWAVES + F.wave, CN_ITEMS, (256 - MG_G) * NWAVES); } else {
        pg8::ProbMoE<0> pr; pr.A = (const char*)(AR + AR_XS); pr.B = (const char*)(ws + WS_WGUE); pr.bes = SZ_WGUE; pr.K = D / 2; pr.nN = 2 * DFE / 256; pr.G = defer_on(F) ? MG_G : F.G; pr.c = c; MOE_SETUP(pr)
        pg8::EpiSwiGLU8 ep{(unsigned char*)HM, DFE, 1.f / (SX8 * SW1_8)}; pg8::gemm_phase<true>(ring, pr, ep); })
    PH(11, pg8::ProbMoE<1> pr; pr.A = (const char*)HM; pr.B = (const char*)(ws + WS_WDE); pr.bes = SZ_WDE; pr.K = DFE / 2; pr.nN = D / 256; pr.G = F.G; pr.c = c; pr.ovf = (int*)(F.ctl + CW_OVF); MOE_SETUP(pr)
        pg8::EpiBf16 ep{YM, D, 0, 1 << 30, 1.f / (SH8 * SW2_8), nullptr, RTAB, (bf16*)(AR + AR_SLAB)}; pg8::gemm_phase<true>(ring, pr, ep);)
    PHL(12, final_phase(F, XN, args.out, YM, tokinfo, gcnt, args.in[15], (const int*)(F.ctl + CW_OVF), (const bf16*)(AR + AR_SLAB));)
#undef IN
#undef SEAM
}

extern "C" void kernel_launch(void* const* d_in, const int* in_sizes, int n_in, void* d_out, int out_size, void* d_ws, size_t ws_size, hipStream_t stream) {
    static int grid = 0;
    if (grid == 0) {
        if (n_in != 16 || in_sizes[0] != M * D || out_size != M * D || ws_size < WS_END) { fprintf(stderr, "kernel_launch: shape/workspace mismatch (n_in %d, ws %zu, need %zu); nothing launched\n", n_in, ws_size, (size_t)WS_END); grid = -1; return; }
        int dev = 0, cus = 0, per_cu = 0;
        if (hipGetDevice(&dev) != hipSuccess || hipDeviceGetAttribute(&cus, hipDeviceAttributeMultiprocessorCount, dev) != hipSuccess) { grid = -1; return; }
        if (hipFuncSetAttribute((const void*)trunk_fwd, hipFuncAttributeMaxDynamicSharedMemorySize, LDS_BYTES) != hipSuccess) { grid = -1; return; }
        if (hipOccupancyMaxActiveBlocksPerMultiprocessor(&per_cu, (const void*)trunk_fwd, NWAVES * 64, LDS_BYTES) != hipSuccess || per_cu < 1) { fprintf(stderr, "kernel_launch: occupancy query says %d\n", per_cu); }
        (void)hipGetLastError();
        grid = cus;
    }
    if (grid < 0) return;
    if (hipMemsetAsync((char*)d_ws + WS_CTL, 0, CTL_ZERO_BYTES, stream) != hipSuccess) return;
    Args a{};
    for (int i = 0; i < 16; ++i) a.in[i] = (const float*)d_in[i];
    a.out = (float*)d_out; a.ws = (unsigned char*)d_ws;
#if MK_ONE_LAUNCH
    a.ph_lo = 0; a.ph_hi = NPH;
    hipLaunchKernelGGL(trunk_fwd, dim3(grid), dim3(NWAVES * 64), LDS_BYTES, stream, a);
#else
    for (int p = 0; p < NPH; ++p) { a.ph_lo = p; a.ph_hi = p + 1; hipLaunchKernelGGL(trunk_fwd, dim3(grid), dim3(NWAVES * 64), LDS_BYTES, stream, a); }
#endif
}
```

```cpp
#include <hip/hip_runtime.h>
#include <hip/hip_bf16.h>
#include <cstdio>
#include <cstdint>

#ifndef PROBE_MASK
#define PROBE_MASK 0u
#endif
#ifndef MK_ONE_LAUNCH
#define MK_ONE_LAUNCH 1
#endif

constexpr int BATCH = 4, SEQ = 4096, D = 1024, M = BATCH * SEQ;
constexpr int DPOOL = 512, DATT = 512, NH = 8, HD = 64, DIN = 2048, PGRP = 128;
constexpr int DFF = 2816, NE = 8, DFE = 3584;
constexpr int PPITCH = DIN + 64;
constexpr float EPS = 1e-6f;
constexpr float C2 = 0.125f * 1.4426950408889634f;

#define GAS __attribute__((address_space(1)))
#define LAS __attribute__((address_space(3)))
typedef unsigned short bf16;
typedef unsigned v4u __attribute__((ext_vector_type(4)));
typedef unsigned v2u __attribute__((ext_vector_type(2)));
typedef float f32x4 __attribute__((ext_vector_type(4)));
typedef float f32x2 __attribute__((ext_vector_type(2)));
typedef short bf16x8 __attribute__((ext_vector_type(8)));
typedef short s16x4 __attribute__((ext_vector_type(4)));
typedef __bf16 bf16x2_t __attribute__((ext_vector_type(2)));
typedef GAS unsigned gu32;
#define RLX_AGENT __ATOMIC_RELAXED, __HIP_MEMORY_SCOPE_AGENT
#define LDS_WAIT() asm volatile("s_waitcnt lgkmcnt(0)" ::: "memory")
#define VM_WAIT() asm volatile("s_waitcnt vmcnt(0)" ::: "memory")
__device__ __forceinline__ unsigned cvtpk(float lo, float hi) { f32x2 v = {lo, hi}; bf16x2_t b = __builtin_convertvector(v, bf16x2_t); return __builtin_bit_cast(unsigned, b); }
constexpr float SX8 = 4.f, SW1_8 = 128.f, SH8 = 8.f, SW2_8 = 256.f;
__device__ __forceinline__ float clamp8(float x) { return __builtin_amdgcn_fmed3f(x, -448.f, 448.f); }
__device__ __forceinline__ unsigned cvt4_fp8(float a, float b, float c, float d) { int w = 0; w = __builtin_amdgcn_cvt_pk_fp8_f32(clamp8(a), clamp8(b), w, false); w = __builtin_amdgcn_cvt_pk_fp8_f32(clamp8(c), clamp8(d), w, true); return (unsigned)w; }
__device__ __forceinline__ float bflo(unsigned w) { return __uint_as_float(w << 16); }
__device__ __forceinline__ float bfhi(unsigned w) { return __uint_as_float(w & 0xffff0000u); }

namespace pg8 {
#define PG8_LAS __attribute__((address_space(3)))
typedef int v4i_t __attribute__((ext_vector_type(4))); typedef int v8i_t __attribute__((ext_vector_type(8)));
constexpr int BM = 256, BK = 64, HALF = 128, HTB = HALF * BK * 2, STAGE_BYTES = 8 * HTB, NXCD = 8, WGM = 8;
__host__ __device__ __forceinline__ int lds_byte(int r, int c) { const int st = (r >> 4) * 2 + (c >> 5), rr = r & 15, cc = c & 31, ob = rr * 64 + cc * 2; return st * 1024 + (ob ^ (((ob >> 9) & 1) << 5)); }
__host__ __device__ __forceinline__ void stage_rc(int b, int& R, int& C) { const int st = b / 1024, sb = b % 1024, swz = sb ^ (((sb >> 9) & 1) << 5); R = (st >> 1) * 16 + swz / 64; C = (st & 1) * 32 + (swz % 64) / 2; }
__host__ __device__ __forceinline__ int perm32(int rho) { const int n = rho >> 4, i = rho & 15; return 8 * (i >> 2) + 4 * n + (i & 3); }

template <class T> struct identity_t; template <class T> struct identity_t<void(T)> { typedef T type; };
struct Unit { int arow, pn, orow, e, lt, kt0, nkt, slab; };

__device__ __forceinline__ bool static_unit_L(int L, int nM, int nN, int& pm, int& pn) {
    const int nwg = __builtin_amdgcn_readfirstlane(nM * nN); if (L >= nwg) return false;
    int wgid = L; { const int q = nwg / NXCD, r = nwg % NXCD, xcd = wgid % NXCD, off = wgid / NXCD; wgid = (xcd < r ? xcd * (q + 1) : r * (q + 1) + (xcd - r) * q) + off; }
    const int nig = WGM * nN, gid = wgid / nig, fm = gid * WGM, gsz = (nM - fm) < WGM ? (nM - fm) : WGM;
    pm = fm + ((wgid % nig) % gsz); pn = (wgid % nig) / gsz; return true;
}
__device__ __forceinline__ bool static_unit(int i, int G, int c, int nM, int nN, int& pm, int& pn) { return static_unit_L(i * G + c, nM, nN, pm, pn); }

struct ProbDense {
    const char* A; const char* B; int K, nM, nN, G, c; int i0 = 0, nmax = 1 << 30; const float* sso = nullptr; PG8_LAS float* rtab = nullptr; bool ablk = false;
    __device__ __forceinline__ bool next(int i, Unit& u) const { int pm, pn; if (i >= nmax || !static_unit(i0 + i, G, c, nM, nN, pm, pn)) return false; u.arow = pm; u.pn = pn; u.orow = pm; u.e = 0; u.lt = 0; u.kt0 = 0; u.nkt = K / BK; u.slab = -1; return true; }
    __device__ __forceinline__ const char* a_base(const Unit& u) const { return A + (size_t)u.arow * 256 * K * 2; }
    __device__ __forceinline__ const char* b_base(const Unit& u) const { return B + (size_t)u.pn * 256 * K * 2; }
};
template <int AMODE> struct ProbMoE {
    const char* A; const char* B; size_t bes; int K, nT, nN, G, c; const PG8_LAS int* tab;
    bool ablk = (AMODE == 1);
    int* ovf = nullptr;
    __device__ __forceinline__ bool next(int i, Unit& u) const {
        int pm, pn, kt0 = 0, nkt = K / BK, slab = -1;
        const int U = nT * nN, L = i * G + c;
        int umain = U, R = 0, S = 1;
        if (ovf) { umain = (U / G) * G; R = U - umain; S = (R > 0 && R * 7 <= G) ? 7 : ((R > 0 && R * 2 <= G) ? 2 : 1); if (S == 1) umain = U; }
        if (L < umain) { if (!static_unit_L(L, nT, nN, pm, pn)) return false; }
        else { const int idx = L - umain; if (idx >= R * S) return false; const int v = idx % R, sl = idx / R;
            if (!static_unit_L(umain + v, nT, nN, pm, pn)) return false;
            nkt = (K / BK) / S; kt0 = sl * nkt; slab = v * S + sl; if (sl == 0 && threadIdx.x == 0) ovf[pm * nN + pn] = v + 1; }
        const int t = pm; int e = 0;
#pragma unroll
        for (int k = 1; k < NE; ++k) e = (t >= tab[k]) ? k : e;
        e = __builtin_amdgcn_readfirstlane(e);
        const int tse = __builtin_amdgcn_readfirstlane(tab[e]);
        u.arow = pm; u.pn = pn; u.orow = t; u.e = e; u.lt = t - tse; u.kt0 = kt0; u.nkt = nkt; u.slab = slab; return true;
    }
    __device__ __forceinline__ const char* a_base(const Unit& u) const { return AMODE == 0 ? A + ((size_t)u.e * M + (size_t)u.lt * 256) * K * 2 : A + (size_t)u.arow * 256 * K * 2; }
    __device__ __forceinline__ const char* b_base(const Unit& u) const { return B + (size_t)u.e * bes + (size_t)u.pn * 256 * K * 2; }
};

__device__ __forceinline__ void row_scales(const float* SS, PG8_LAS float* rtab, int orow, int wr, int wc, int fr, int fq) {
    const int t = (wr * 4 + wc) * 64 + fq * 16 + fr, row = t >> 1, half = t & 1;
    const f32x4 a = *(const f32x4*)(SS + (size_t)(orow * BM + row) * 16 + half * 8), b = *(const f32x4*)(SS + (size_t)(orow * BM + row) * 16 + half * 8 + 4);
    float sm = ((a[0] + a[1]) + (a[2] + a[3])) + ((b[0] + b[1]) + (b[2] + b[3]));
    sm += __shfl_xor(sm, 1);
    if (half == 0) rtab[row] = 1.f / sqrtf(sm * (1.f / 1024.f) + 1e-6f);
    asm volatile("s_waitcnt lgkmcnt(0)\n\ts_barrier" ::: "memory");
}
struct EpiBf16 {
    static constexpr bool PERM = true;
    bf16* O; int ldc; int sc_lo, sc_hi; float scale; const float* SS; PG8_LAS float* rtab; bf16* SLAB = nullptr;
    __device__ __forceinline__ void operator()(const f32x4 (&acc)[2][2][4][2], const Unit& u, int wr, int wc, int fr, int fq) const {
        int row0 = u.orow * BM + wr * 64 + fr, col0 = u.pn * BM + wc * 32 + 8 * fq; bf16* Ob = O; int ld = ldc;
        if (u.slab >= 0) { Ob = SLAB + (size_t)u.slab * (BM * BM); ld = BM; row0 = wr * 64 + fr; col0 = wc * 32 + 8 * fq; }
        const float sc0 = (u.pn >= sc_lo && u.pn < sc_hi) ? scale : 1.f;
        if (SS) row_scales(SS, rtab, u.orow, wr, wc, fr, fq);
#pragma unroll
        for (int ai = 0; ai < 2; ++ai)
#pragma unroll
            for (int m = 0; m < 4; ++m) { bf16* rowp = Ob + (size_t)(row0 + ai * HALF + m * 16) * ld + col0; const float sc = SS ? sc0 * rtab[wr * 64 + fr + ai * HALF + m * 16] : sc0;
#pragma unroll
                for (int bj = 0; bj < 2; ++bj) { const f32x4 v0 = acc[ai][bj][m][0] * sc, v1 = acc[ai][bj][m][1] * sc;
                    v4u w; w.x = cvtpk(v0[0], v0[1]); w.y = cvtpk(v0[2], v0[3]); w.z = cvtpk(v1[0], v1[1]); w.w = cvtpk(v1[2], v1[3]);
                    *(v4u*)(rowp + bj * HALF) = w; } }
    }
};
template <bool BASE_F32, bool HAS_X8 = false, bool SCALED = false> struct EpiRes {
    static constexpr bool PERM = true;
    const void* base; bf16* X; int ldc; float* SS; unsigned char* X8 = nullptr; float ascale = 1.f;
    __device__ __forceinline__ void operator()(const f32x4 (&acc)[2][2][4][2], const Unit& u, int wr, int wc, int fr, int fq) const {
        const int row0 = u.orow * BM + wr * 64 + fr, col0 = u.pn * BM + wc * 32 + 8 * fq;
#pragma unroll
        for (int ai = 0; ai < 2; ++ai)
#pragma unroll
            for (int m = 0; m < 4; ++m) { const size_t off = (size_t)(row0 + ai * HALF + m * 16) * ldc + col0; float sq = 0.f;
#pragma unroll
                for (int bj = 0; bj < 2; ++bj) { f32x4 b0, b1;
                    if (BASE_F32) { b0 = *(const f32x4*)((const float*)base + off + bj * HALF); b1 = *(const f32x4*)((const float*)base + off + bj * HALF + 4); }
                    else { const v4u w = *(const v4u*)((const bf16*)base + off + bj * HALF); b0 = (f32x4){bflo(w.x), bfhi(w.x), bflo(w.y), bfhi(w.y)}; b1 = (f32x4){bflo(w.z), bfhi(w.z), bflo(w.w), bfhi(w.w)}; }
                    const f32x4 x0 = SCALED ? b0 + acc[ai][bj][m][0] * ascale : b0 + acc[ai][bj][m][0], x1 = SCALED ? b1 + acc[ai][bj][m][1] * ascale : b1 + acc[ai][bj][m][1];
                    v4u o; o.x = cvtpk(x0[0], x0[1]); o.y = cvtpk(x0[2], x0[3]); o.z = cvtpk(x1[0], x1[1]); o.w = cvtpk(x1[2], x1[3]);
                    *(v4u*)(X + off + bj * HALF) = o;
                    if constexpr (HAS_X8) { v2u o8; o8.x = cvt4_fp8(x0[0] * SX8, x0[1] * SX8, x0[2] * SX8, x0[3] * SX8); o8.y = cvt4_fp8(x1[0] * SX8, x1[1] * SX8, x1[2] * SX8, x1[3] * SX8); *(v2u*)(X8 + off + bj * HALF) = o8; }
                    sq += ((x0[0] * x0[0] + x0[1] * x0[1]) + (x0[2] * x0[2] + x0[3] * x0[3])) + ((x1[0] * x1[0] + x1[1] * x1[1]) + (x1[2] * x1[2] + x1[3] * x1[3])); }
                if (SS) { sq += __shfl_xor(sq, 16); sq += __shfl_xor(sq, 32); if (fq == 0) SS[(size_t)(row0 + ai * HALF + m * 16) * 16 + u.pn * 4 + wc] = sq; } }
    }
};
struct EpiSwiGLU {
    static constexpr bool PERM = true;
    bf16* H; int ldh; const float* SS; PG8_LAS float* rtab;
    __device__ __forceinline__ void operator()(const f32x4 (&acc)[2][2][4][2], const Unit& u, int wr, int wc, int fr, int fq) const {
        const int row0 = u.orow * BM + wr * 64 + fr, col0 = u.pn * HALF + wc * 32 + 8 * fq;
        if (SS) row_scales(SS, rtab, u.orow, wr, wc, fr, fq);
#pragma unroll
        for (int ai = 0; ai < 2; ++ai)
#pragma unroll
            for (int m = 0; m < 4; ++m) { bf16* rowp = H + (size_t)(row0 + ai * HALF + m * 16) * ldh + col0; const float rs = SS ? rtab[wr * 64 + fr + ai * HALF + m * 16] : 1.f;
                const float c1 = -1.4426950408889634f * rs, c2 = rs * rs; unsigned w[4];
#pragma unroll
                for (int n = 0; n < 2; ++n)
#pragma unroll
                    for (int jp = 0; jp < 2; ++jp) { const f32x2 g = {acc[ai][0][m][n][2 * jp], acc[ai][0][m][n][2 * jp + 1]}, up = {acc[ai][1][m][n][2 * jp], acc[ai][1][m][n][2 * jp + 1]};
                        const f32x2 t = g * c1; f32x2 e; e.x = __builtin_amdgcn_exp2f(t.x); e.y = __builtin_amdgcn_exp2f(t.y); const f32x2 d = e + 1.0f; f32x2 r; r.x = __builtin_amdgcn_rcpf(d.x); r.y = __builtin_amdgcn_rcpf(d.y);
                        const f32x2 hh = (g * up) * (r * c2); w[n * 2 + jp] = cvtpk(hh.x, hh.y); }
                v4u wv; wv.x = w[0]; wv.y = w[1]; wv.z = w[2]; wv.w = w[3];
                *(v4u*)rowp = wv; }
    }
};
struct EpiSwiGLU8 {
    static constexpr bool PERM = true;
    unsigned char* H; int ldh; float inscale; const float* SS = nullptr; PG8_LAS float* rtab = nullptr;
    __device__ __forceinline__ void operator()(const f32x4 (&acc)[2][2][4][2], const Unit& u, int wr, int wc, int fr, int fq) const {
        const int row0 = u.orow * BM + wr * 64 + fr, col0 = u.pn * HALF + wc * 32 + 8 * fq;
        if (SS) row_scales(SS, rtab, u.orow, wr, wc, fr, fq);
#pragma unroll
        for (int ai = 0; ai < 2; ++ai)
#pragma unroll
            for (int m = 0; m < 4; ++m) { unsigned char* rowp = H + ((size_t)u.orow * (ldh / 128) + u.pn) * 32768 + wc * 8192 + (wr * 64 + fr + ai * HALF + m * 16) * 32 + 8 * fq; unsigned wq[2];
                const float is_ = SS ? inscale * rtab[wr * 64 + fr + ai * HALF + m * 16] : inscale; const float c1 = -1.4426950408889634f * is_, c2 = is_ * is_ * SH8;
#pragma unroll
                for (int n = 0; n < 2; ++n) { f32x2 hh[2];
#pragma unroll
                    for (int jp = 0; jp < 2; ++jp) { const f32x2 g = {acc[ai][0][m][n][2 * jp], acc[ai][0][m][n][2 * jp + 1]}, up = {acc[ai][1][m][n][2 * jp], acc[ai][1][m][n][2 * jp + 1]};
                        const f32x2 t = g * c1; f32x2 e; e.x = __builtin_amdgcn_exp2f(t.x); e.y = __builtin_amdgcn_exp2f(t.y); const f32x2 d = e + 1.0f; f32x2 r; r.x = __builtin_amdgcn_rcpf(d.x); r.y = __builtin_amdgcn_rcpf(d.y);
                        hh[jp] = (g * up) * (r * c2); }
                    wq[n] = cvt4_fp8(hh[0].x, hh[0].y, hh[1].x, hh[1].y); }
                v2u w; w.x = wq[0]; w.y = wq[1];
                __builtin_nontemporal_store(w, (v2u*)rowp); }
    }
};

template <bool FP8, bool MIDK = false, class Prob, class Epi>
__device__ __forceinline__ void gemm_phase(PG8_LAS unsigned char* lds, const Prob& P, const Epi& E) {
    int tid = threadIdx.x; asm volatile("" : "+v"(tid));
    const int wid = __builtin_amdgcn_readfirstlane(tid >> 6), lane = tid & 63, wr = wid >> 2, wc = wid & 3, fr = lane & 15, fq = lane >> 4;
    const int K = P.K;
    const bool ablk = P.ablk;
    int Rr[2], Cc[2]; unsigned voffA[2], voffB[2];
    stage_rc(tid * 16, Rr[0], Cc[0]); Rr[1] = Rr[0] + 64; Cc[1] = Cc[0];
#pragma unroll
    for (int i = 0; i < 2; ++i) { const int Rb = Epi::PERM ? ((Rr[i] & ~31) + perm32(Rr[i] & 31)) : Rr[i]; voffA[i] = ablk ? (unsigned)(((2 * Cc[i]) >> 5) * 8192 + Rr[i] * 32 + ((2 * Cc[i]) & 31)) : (unsigned)(Rr[i] * K + Cc[i]) * 2u; voffB[i] = (unsigned)(Rb * K + Cc[i]) * 2u; }
    const size_t kstep = (size_t)(BK * 2), kstepA = ablk ? (size_t)32768 : kstep;
    const size_t hstep = (size_t)HALF * K * 2, qstep = (size_t)64 * K * 2, hstepA = ablk ? (size_t)4096 : hstep, qstepA = ablk ? (size_t)2048 : qstep;
    const unsigned ldsw = (unsigned)wid * 1024u;
    const int aoff = lds_byte(wr * 64 + fr, fq * 8), boff = lds_byte(wc * 32 + fr, fq * 8);
#define PG8_SA(b, h) (((b) * 2 + (h)) * HTB)
#define PG8_SB(b, h) ((4 + (b) * 2 + (h)) * HTB)
#define PG8_STAGE_Q(bufoff, gbase, voff, qs) do { unsigned _o = (voff)[0]; asm volatile("" : "+v"(_o));     \
        _Pragma("unroll") for (int _i = 0; _i < 2; ++_i) \
        __builtin_amdgcn_global_load_lds((const unsigned*)((const char*)(gbase) + (size_t)_i * (qs) + _o), (PG8_LAS unsigned*)(lds + (bufoff) + ldsw + _i * 8192), 16, 0, 0); } while (0)
#define PG8_STAGE(bufoff, gbase, voff) PG8_STAGE_Q(bufoff, gbase, voff, qstep)
#define PG8_STAGE_A(bufoff, a, h, goff) PG8_STAGE_Q(bufoff, (a) + (h) * hstepA, voffA, qstepA)
#define PG8_STAGE_A2(bufoff, a, h) PG8_STAGE_Q(bufoff, (a) + (h) * hstepA, voffA, qstepA)
#define PG8_LDA(dst, b, h) do { _Pragma("unroll") for (int m = 0; m < 4; ++m) _Pragma("unroll") for (int k = 0; k < 2; ++k) dst[m][k] = *(const PG8_LAS bf16x8*)(lds + PG8_SA(b, h) + aoff + m * 2048 + k * 1024); } while (0)
#define PG8_LDB(dst, b, h) do { _Pragma("unroll") for (int n = 0; n < 2; ++n) _Pragma("unroll") for (int k = 0; k < 2; ++k) dst[n][k] = *(const PG8_LAS bf16x8*)(lds + PG8_SB(b, h) + boff + n * 2048 + k * 1024); } while (0)
#define PG8_MMA(ai, bj, At, Bt) do { __builtin_amdgcn_s_setprio(1); _Pragma("unroll") for (int m = 0; m < 4; ++m) _Pragma("unroll") for (int n = 0; n < 2; ++n) _Pragma("unroll") for (int k = 0; k < 2; ++k) \
        acc[ai][bj][m][n] = __builtin_amdgcn_mfma_f32_16x16x32_bf16(Bt[n][k], At[m][k], acc[ai][bj][m][n], 0, 0, 0); __builtin_amdgcn_s_setprio(0); } while (0)
#define PG8_CAT8(x, y) __builtin_shufflevector((x), (y), 0, 1, 2, 3, 4, 5, 6, 7)
#define PG8_LDA8(dst, b, h) do { _Pragma("unroll") for (int m = 0; m < 4; ++m) dst[m] = PG8_CAT8(*(const PG8_LAS v4i_t*)(lds + PG8_SA(b, h) + aoff + m * 2048), *(const PG8_LAS v4i_t*)(lds + PG8_SA(b, h) + aoff + m * 2048 + 1024)); } while (0)
#define PG8_LDB8(dst, b, h) do { _Pragma("unroll") for (int n = 0; n < 2; ++n) dst[n] = PG8_CAT8(*(const PG8_LAS v4i_t*)(lds + PG8_SB(b, h) + boff + n * 2048), *(const PG8_LAS v4i_t*)(lds + PG8_SB(b, h) + boff + n * 2048 + 1024)); } while (0)
#define PG8_MMA8(ai, bj, At, Bt) do { __builtin_amdgcn_s_setprio(1); _Pragma("unroll") for (int m = 0; m < 4; ++m) _Pragma("unroll") for (int n = 0; n < 2; ++n) \
        acc[ai][bj][m][n] = __builtin_amdgcn_mfma_scale_f32_16x16x128_f8f6f4(Bt[n], At[m], acc[ai][bj][m][n], 0, 0, 0, 0x7f7f7f7f, 0, 0x7f7f7f7f); __builtin_amdgcn_s_setprio(0); } while (0)
#define PG8_MM(ai, bj, At_, B_) do { if constexpr (FP8) PG8_MMA8(ai, bj, At8, B_##8); else PG8_MMA(ai, bj, At_, B_); } while (0)
#define PG8_LA(b, h) do { if constexpr (FP8) PG8_LDA8(At8, b, h); else PG8_LDA(At, b, h); } while (0)
#define PG8_LB(dst, b, h) do { if constexpr (FP8) PG8_LDB8(dst##8, b, h); else PG8_LDB(dst, b, h); } while (0)
#define PG8_WAIT_V(n) asm volatile("s_waitcnt vmcnt(" #n ")" ::: "memory")
#define PG8_WAIT_L(n) asm volatile("s_waitcnt lgkmcnt(" #n ")" ::: "memory")
#define PG8_BAR __builtin_amdgcn_s_barrier()
#define PG8_SCHED __builtin_amdgcn_sched_barrier(0)
    Unit cur, nxt; int ui = 0;
    if (!P.next(0, cur)) return;
    if constexpr (MIDK) { const int row = tid >> 1, half = tid & 1; const f32x4 a = *(const f32x4*)(P.sso + (size_t)(cur.orow * BM + row) * 8 + half * 4);
        float sm = (a[0] + a[1]) + (a[2] + a[3]); sm += __shfl_xor(sm, 1); if (half == 0) P.rtab[row] = 1.f / sqrtf(sm * (1.f / 512.f) + 1e-6f);
        asm volatile("s_waitcnt lgkmcnt(0)\n\ts_barrier" ::: "memory"); }
    f32x4 acc[2][2][4][2];
#pragma unroll
    for (int a = 0; a < 2; ++a)
#pragma unroll
        for (int b = 0; b < 2; ++b)
#pragma unroll
            for (int m = 0; m < 4; ++m)
#pragma unroll
                for (int n = 0; n < 2; ++n) acc[a][b][m][n] = (f32x4){0.f, 0.f, 0.f, 0.f};
    bf16x8 At[4][2], B0[2][2], B1[2][2]; v8i_t At8[4], B08[2], B18[2];
    const char* cA = P.a_base(cur) + (size_t)cur.kt0 * kstepA; const char* cB = P.b_base(cur) + (size_t)cur.kt0 * kstep;
    PG8_STAGE(PG8_SB(0, 0), cB, voffB); PG8_STAGE(PG8_SB(0, 1), cB + hstep, voffB); PG8_STAGE_A(PG8_SA(0, 0), cA, 0, cOff); PG8_STAGE_A(PG8_SA(0, 1), cA, 1, cOff);
    if (wr == 1) PG8_BAR;
    PG8_WAIT_V(2); PG8_BAR;
    PG8_STAGE(PG8_SB(1, 0), cB + kstep, voffB); PG8_STAGE_A(PG8_SA(1, 0), cA + kstepA, 0, cOff); PG8_STAGE(PG8_SB(1, 1), cB + hstep + kstep, voffB);
    PG8_WAIT_V(6); PG8_BAR;
    for (;;) {
        const bool has_next = P.next(ui + 1, nxt);
        const char* nA = cA; const char* nB = cB;
        if (has_next) { nA = P.a_base(nxt) + (size_t)nxt.kt0 * kstepA; nB = P.b_base(nxt) + (size_t)nxt.kt0 * kstep; }
        const int cnt = cur.nkt;
        for (int t = 0; t < cnt; t += 2) {
            if constexpr (MIDK) { if (t == cnt / 2) {
#pragma unroll
                for (int ai = 0; ai < 2; ++ai)
#pragma unroll
                    for (int m = 0; m < 4; ++m) { const float rsc = P.rtab[wr * 64 + fr + ai * HALF + m * 16];
#pragma unroll
                        for (int bj = 0; bj < 2; ++bj)
#pragma unroll
                            for (int n = 0; n < 2; ++n) acc[ai][bj][m][n] = acc[ai][bj][m][n] * rsc; } } }
            const bool last = (t == cnt - 2);
            const char* a1 = cA + (size_t)(t + 1) * kstepA;
            const char* a2 = last ? nA : cA + (size_t)(t + 2) * kstepA; const char* b2 = last ? nB : cB + (size_t)(t + 2) * kstep;
            const char* a3 = a2 + kstepA; const char* b3 = b2 + kstep;

            PG8_LB(B0, 0, 0); PG8_LB(B1, 0, 1); PG8_SCHED; PG8_LA(0, 0); PG8_STAGE_A(PG8_SA(1, 1), a1, 1, cOff);
            PG8_WAIT_V(8); PG8_WAIT_L(0); PG8_BAR; PG8_MM(0, 0, At, B0); PG8_MM(0, 1, At, B1); PG8_BAR; PG8_SCHED;
            PG8_LA(0, 1); PG8_STAGE(PG8_SB(0, 0), b2, voffB); PG8_STAGE(PG8_SB(0, 1), b2 + hstep, voffB); PG8_STAGE_A2(PG8_SA(0, 0), a2, 0);
            PG8_WAIT_V(8); PG8_WAIT_L(0); PG8_BAR; PG8_MM(1, 0, At, B0); PG8_MM(1, 1, At, B1); PG8_BAR; PG8_SCHED;
            PG8_LB(B0, 1, 0); PG8_LB(B1, 1, 1); PG8_SCHED; PG8_LA(1, 0); PG8_STAGE_A2(PG8_SA(0, 1), a2, 1);
            PG8_WAIT_V(8); PG8_WAIT_L(0); PG8_BAR; PG8_MM(0, 0, At, B0); PG8_MM(0, 1, At, B1); PG8_BAR; PG8_SCHED;
            PG8_LA(1, 1); PG8_STAGE(PG8_SB(1, 0), b3, voffB); PG8_STAGE(PG8_SB(1, 1), b3 + hstep, voffB); PG8_STAGE_A2(PG8_SA(1, 0), a3, 0);
            PG8_WAIT_V(8); PG8_WAIT_L(0); PG8_BAR; PG8_MM(1, 0, At, B0); PG8_MM(1, 1, At, B1); PG8_BAR; PG8_SCHED;
        }
        if (wr == 0) PG8_BAR;
        { int t_ = (int)__builtin_amdgcn_mbcnt_hi(~0u, __builtin_amdgcn_mbcnt_lo(~0u, 0u)); asm volatile("" : "+v"(t_)); E(acc, cur, wr, wc, t_ & 15, (t_ >> 4) & 3); }
        if (!has_next) break;
#pragma unroll
        for (int a = 0; a < 2; ++a)
#pragma unroll
            for (int b = 0; b < 2; ++b)
#pragma unroll
                for (int m = 0; m < 4; ++m)
#pragma unroll
                    for (int n = 0; n < 2; ++n) acc[a][b][m][n] = (f32x4){0.f, 0.f, 0.f, 0.f};
        cur = nxt; cA = nA; cB = nB; ++ui;
        if (wr == 1) PG8_BAR;
    }
    PG8_WAIT_V(0);
    PG8_BAR;
#undef PG8_SA
#undef PG8_SB
#undef PG8_STAGE
#undef PG8_STAGE_Q
#undef PG8_STAGE_A
#undef PG8_STAGE_A2
#undef PG8_LDA
#undef PG8_LDB
#undef PG8_MMA
#undef PG8_MMA8
#undef PG8_MM
#undef PG8_CAT8
#undef PG8_LDA8
#undef PG8_LDB8
#undef PG8_LA
#undef PG8_LB
#undef PG8_WAIT_V
#undef PG8_WAIT_L
#undef PG8_BAR
#undef PG8_SCHED
}
}

constexpr size_t MiB = 1u << 20;
constexpr size_t WS_CTL = 0, CTL_ZERO_BYTES = 1 * MiB;
constexpr size_t SZ_WIN = (size_t)DIN * D * 2, SZ_WOUT = (size_t)D * D * 2, SZ_WGU = (size_t)2 * DFF * D * 2, SZ_WD = (size_t)D * DFF;
constexpr size_t SZ_WGUE = (size_t)2 * DFE * D, SZ_WDE = (size_t)D * DFE;
constexpr size_t WS_WIN = 1 * MiB;
constexpr size_t WS_WOUT = WS_WIN + 2 * SZ_WIN;
constexpr size_t WS_WGU = WS_WOUT + 2 * SZ_WOUT;
constexpr size_t WS_WD = WS_WGU + SZ_WGU;
constexpr size_t WS_WGUE = WS_WD + SZ_WD;
constexpr size_t WS_WDE = WS_WGUE + NE * SZ_WGUE;
constexpr size_t WS_ROUTE = WS_WDE + NE * SZ_WDE;
constexpr size_t SZ_ROUTE = (size_t)M * 32;
constexpr size_t WS_WPOOL = WS_ROUTE + SZ_ROUTE, SZ_WPOOL = (size_t)2 * 4 * PGRP * PGRP * 2;
constexpr size_t WS_SS = WS_WPOOL + SZ_WPOOL, SZ_SS = (size_t)M * 16 * 4;
constexpr size_t WS_SSO = WS_SS + SZ_SS, SZ_SSO = (size_t)M * 8 * 4;
constexpr size_t WS_XN = (WS_SSO + SZ_SSO + MiB - 1) / MiB * MiB;
constexpr size_t WS_ARENA = WS_XN + (size_t)M * D * 2;
constexpr size_t AR_PROJ = 0, AR_O = AR_PROJ + (size_t)M * PPITCH * 2, AR_Y = AR_O + (size_t)M * DATT * 2, AR_MIX_END = AR_Y + (size_t)M * D * 2;
constexpr size_t AR_X8 = 0, AR_H = (size_t)32 * MiB, AR_H_END = AR_H + (size_t)M * DFF;
constexpr int TCH = 136, MAXT = 136;
constexpr size_t AR_XS = 0, AR_YM = 0, AR_HM = (size_t)NE * M * D, AR_MOE_END = AR_HM + (size_t)MAXT * 256 * DFE;
constexpr size_t AR_SLAB = AR_YM + (size_t)MAXT * 256 * D * 2, SZ_SLAB = (size_t)256 * 256 * 256 * 2;
static_assert(AR_SLAB + SZ_SLAB <= (size_t)NE * M * D, "YM and the slabs overlay XS");
constexpr size_t AR_SIZE = AR_MOE_END > AR_MIX_END ? (AR_MOE_END > AR_H_END ? AR_MOE_END : AR_H_END) : (AR_MIX_END > AR_H_END ? AR_MIX_END : AR_H_END);
constexpr size_t WS_END = WS_ARENA + AR_SIZE;
constexpr int CW_TMO = 0, CW_CODE = 1;
constexpr int CW_ECNT = 64;
constexpr int CW_OVF = 256;
constexpr int CW_BAR = 4096;

constexpr int RING_OFF = 0, RING_BYTES = 131072;
constexpr int LDSCTL_OFF = 146432, MISC_OFF = LDSCTL_OFF + 320;
constexpr int LDS_BYTES = 147456;
constexpr int NWAVES = 8;

#define XB_TMO      128
#define XB_XCNT(j)  (256  + 64 * (j))
#define XB_XSUB(j)  (1280 + 64 * (j))
#define XB_XGEN(j)  (2304 + 64 * (j))
#define XB_TOP      3328
#define XB_TOPGEN   3392
#define XCD_BAR_WORDS 3456
#define XB_SPIN_CAP (1u << 18)
__device__ __forceinline__ unsigned xb_ld(unsigned* p)              { return __hip_atomic_load(p, __ATOMIC_RELAXED, __HIP_MEMORY_SCOPE_AGENT); }
__device__ __forceinline__ unsigned xb_add(unsigned* p, unsigned v) { return __hip_atomic_fetch_add(p, v, __ATOMIC_RELAXED, __HIP_MEMORY_SCOPE_AGENT); }
__device__ __forceinline__ unsigned xb_xcc_id() { return (unsigned)__builtin_amdgcn_s_getreg((3 << 11) | 20) & 0xFu; }
#define XB_SPIN(cond, bar) do { unsigned _sp = 0; while (cond) { __builtin_amdgcn_s_sleep(1); \
    if ((++_sp & 255u) == 0u) { if (xb_ld(&(bar)[XB_TMO])) break; if (_sp > XB_SPIN_CAP) { atomicAdd(&(bar)[XB_TMO], 1u); break; } } } } while (0)
struct XcdBarrier { unsigned* bar; unsigned x; volatile LAS unsigned* st; };
__device__ __forceinline__ XcdBarrier xcd_barrier_post(unsigned* bar, volatile LAS unsigned* st) {
    XcdBarrier b; b.bar = bar; b.x = xb_xcc_id(); b.st = st;
    if (threadIdx.x == 0) (void)xb_add(&bar[XB_XCNT(b.x)], 1u);
    return b;
}
__device__ __forceinline__ void xcd_barrier_complete(unsigned* bar, unsigned x, unsigned& nloc, unsigned& nx) {
    const unsigned G = gridDim.x * gridDim.y * gridDim.z;
    unsigned sum, cnt, mine, sp = 0u;
    for (;;) {
        sum = 0u; cnt = 0u; mine = 0u;
#pragma unroll
        for (unsigned j = 0; j < 16; ++j) { const unsigned c = xb_ld(&bar[XB_XCNT(j)]); sum += c; cnt += (c > 0u) ? 1u : 0u; mine = (j == x) ? c : mine; }
        if (sum == G) break;
        __builtin_amdgcn_s_sleep(1);
        if ((++sp & 255u) == 0u) { if (xb_ld(&bar[XB_TMO])) break; if (sp > XB_SPIN_CAP) { atomicAdd(&bar[XB_TMO], 1u); break; } }
    }
    nloc = mine > 0u ? mine : 1u; nx = cnt > 0u ? cnt : 1u;
}
__device__ __forceinline__ void xcd_barrier(const XcdBarrier& b, bool leader) {
    asm volatile("s_waitcnt vmcnt(0)" ::: "memory");
    __syncthreads();
    if (leader) {
        unsigned* bar = b.bar;
        __builtin_amdgcn_s_waitcnt(0);
        unsigned nloc = b.st[0], nx = b.st[1];
        if (nloc == 0u) { xcd_barrier_complete(bar, b.x, nloc, nx); b.st[0] = nloc; b.st[1] = nx; }
        const unsigned old = xb_add(&bar[XB_XSUB(b.x)], 1u);
        const unsigned gen = old / nloc;
        if (old + 1u == (gen + 1u) * nloc) {
            __builtin_amdgcn_fence(__ATOMIC_RELEASE, "agent");
            asm volatile("s_waitcnt vmcnt(0)" ::: "memory");
            const unsigned og = xb_add(&bar[XB_TOP], 1u);
            const unsigned tg = og / nx;
            if (og + 1u == (tg + 1u) * nx) xb_add(&bar[XB_TOPGEN], 1u);
            else XB_SPIN(xb_ld(&bar[XB_TOPGEN]) == tg, bar);
            __builtin_amdgcn_fence(__ATOMIC_ACQUIRE, "agent");
            xb_add(&bar[XB_XGEN(b.x)], 1u);
            asm volatile("s_waitcnt vmcnt(0)" ::: "memory");
        } else {
            XB_SPIN(xb_ld(&bar[XB_XGEN(b.x)]) == gen, bar);
            __builtin_amdgcn_fence(__ATOMIC_ACQUIRE, "agent");
            asm volatile("s_waitcnt vmcnt(0)" ::: "memory");
        }
    }
    __syncthreads();
}

struct Args { const float* in[16]; float* out; unsigned char* ws; int ph_lo, ph_hi; };
struct Frame {
    LAS unsigned char* lds;
    volatile LAS unsigned* MISC;
    gu32* ctl;
    int vcu, G, wave;
};
__device__ __forceinline__ int lane_id() { return (int)__builtin_amdgcn_mbcnt_hi(~0u, __builtin_amdgcn_mbcnt_lo(~0u, 0u)); }
__device__ __forceinline__ int fresh_tid() { int t = threadIdx.x; asm volatile("" : "+v"(t)); return t; }
#define PHASE_IDS() const int tid_ = fresh_tid(); const int ph_lane = tid_ & 63; const int ph_wave = __builtin_amdgcn_readfirstlane(tid_ >> 6); (void)ph_lane; (void)ph_wave
__device__ __forceinline__ float wave_sum(float v) {
#pragma unroll
    for (int o = 1; o < 64; o <<= 1) v += __shfl_xor(v, o);
    return v;
}

struct CvtJob { const float* src; unsigned char* dst; const float* gk; int N, K, r0, k0, f8, gkmax; float scale; int frag; };
__device__ __forceinline__ void cvt_load(const CvtJob& j, f32x4 (&v)[16], int lane) {
    const float* p = j.src + (size_t)(lane >> 4) * j.N + 4 * (lane & 15);
#pragma unroll
    for (int i = 0; i < 16; ++i) v[i] = __builtin_nontemporal_load((const GAS f32x4*)(p + (size_t)(4 * i) * j.N));
}
__device__ __forceinline__ void cvt_store(const CvtJob& j, const f32x4 (&v)[16], LAS float* scr, int lane) {
#pragma unroll
    for (int i = 0; i < 16; ++i) { LAS float* w = scr + (4 * i + (lane >> 4)) * 65 + 4 * (lane & 15); w[0] = v[i].x; w[1] = v[i].y; w[2] = v[i].z; w[3] = v[i].w; }
    LDS_WAIT(); asm volatile("" ::: "memory");
    const int c = lane & 7, nn = lane >> 3; const float sc = j.scale;
    f32x4 ga = (f32x4){sc, sc, sc, sc}, gb = ga;
    if (j.gk && j.k0 < j.gkmax) { ga = ga * *(const GAS f32x4*)(j.gk + j.k0 + 8 * c); gb = gb * *(const GAS f32x4*)(j.gk + j.k0 + 8 * c + 4); }
#pragma unroll
    for (int jj = 0; jj < 8; ++jj) { const int n = nn + 8 * jj; const LAS float* s = scr + (8 * c) * 65 + n;
        const float f0 = s[0] * ga.x, f1 = s[65] * ga.y, f2 = s[130] * ga.z, f3 = s[195] * ga.w, f4 = s[260] * gb.x, f5 = s[325] * gb.y, f6 = s[390] * gb.z, f7 = s[455] * gb.w;
        if (j.f8) { v2u o; o.x = cvt4_fp8(f0, f1, f2, f3); o.y = cvt4_fp8(f4, f5, f6, f7); __builtin_nontemporal_store(o, (GAS v2u*)(j.dst + (size_t)(j.r0 + n) * j.K + j.k0 + 8 * c)); }
        else { v4u o; o.x = cvtpk(f0, f1); o.y = cvtpk(f2, f3); o.z = cvtpk(f4, f5); o.w = cvtpk(f6, f7);
            if (j.frag) { const int e = j.r0 + n, x = (j.k0 >> 3) + c; *(GAS v4u*)(j.dst + ((((e >> 6) * 2 + ((e >> 5) & 1)) * 8 + (x >> 1)) * 1024 + ((x & 1) * 32 + (e & 31)) * 16)) = o; }
            else *(GAS v4u*)(j.dst + ((size_t)(j.r0 + n) * j.K + j.k0 + 8 * c) * 2) = o; } }
    LDS_WAIT(); asm volatile("" ::: "memory");
}
__device__ __forceinline__ void cvt_job(CvtJob& j, const float* W, int K, int N, void* WT, int kind, int f8, float scale, int item, const float* gk = nullptr) {
    j.gk = gk; j.gkmax = 1 << 30; j.frag = 0;
    const int nblk = N / 64, kb = item / nblk, nb = item % nblk, k0 = 64 * kb, n0 = 64 * nb;
    j.src = W + (size_t)k0 * N + n0; j.dst = (unsigned char*)WT; j.N = N; j.K = K; j.k0 = k0; j.f8 = f8; j.scale = scale;
    j.r0 = (kind == 0) ? n0 : (256 * (n0 / 128) + (n0 % 128) + (kind == 2 ? 128 : 0));
}
__device__ __forceinline__ void norm_rows(Frame& F, const float* X, const float* gain, bf16* XN) {
    PHASE_IDS();
    const int gw = F.vcu * NWAVES + ph_wave, NGW = F.G * NWAVES;
    f32x4 g[4];
#pragma unroll
    for (int j = 0; j < 4; ++j) g[j] = ((const GAS f32x4*)gain)[ph_lane + 64 * j];
    for (int m = gw; m < M; m += 2 * NGW) {
        const int m2 = (m + NGW < M) ? m + NGW : m;
        const GAS f32x4* xa = (const GAS f32x4*)(X + (size_t)m * D) + ph_lane; const GAS f32x4* xb = (const GAS f32x4*)(X + (size_t)m2 * D) + ph_lane;
        f32x4 v[4], u[4]; float s = 0.f, t = 0.f;
#pragma unroll
        for (int j = 0; j < 4; ++j) { v[j] = xa[64 * j]; u[j] = xb[64 * j]; }
#pragma unroll
        for (int j = 0; j < 4; ++j) { s += (v[j].x * v[j].x + v[j].y * v[j].y) + (v[j].z * v[j].z + v[j].w * v[j].w); t += (u[j].x * u[j].x + u[j].y * u[j].y) + (u[j].z * u[j].z + u[j].w * u[j].w); }
        const float r = 1.f / sqrtf(wave_sum(s) * (1.f / D) + EPS), r2 = 1.f / sqrtf(wave_sum(t) * (1.f / D) + EPS);
        GAS v2u* oa = (GAS v2u*)(XN + (size_t)m * D) + ph_lane; GAS v2u* ob = (GAS v2u*)(XN + (size_t)m2 * D) + ph_lane;
#pragma unroll
        for (int j = 0; j < 4; ++j) { const f32x4 h = v[j] * r * g[j]; v2u w; w.x = cvtpk(h.x, h.y); w.y = cvtpk(h.z, h.w); oa[64 * j] = w; }
        if (m2 != m) {
#pragma unroll
            for (int j = 0; j < 4; ++j) { const f32x4 h = u[j] * r2 * g[j]; v2u w; w.x = cvtpk(h.x, h.y); w.y = cvtpk(h.z, h.w); ob[64 * j] = w; } }
    }
}
constexpr int CI_IN = (D / 64) * (DIN / 64), CI_OUT = (D / 64) * (D / 64), CI_G = (D / 64) * (DFF / 64), CI_D = (DFF / 64) * (D / 64), CI_E = (D / 64) * (DFE / 64), CI_P = 4;
constexpr int DEFER_PER_WAVE = 34, DEFER_TAIL = 4, DEFER_MOE = 38;
constexpr int CN_SMALL = 2 * CI_IN + 2 * CI_OUT + 2 * CI_G + CI_D + 8 * CI_P, CN_ITEMS = CN_SMALL + 24 * CI_E;
__device__ __forceinline__ void cvt_decode(CvtJob& j, const Args& args, unsigned char* ws, int it) {
    int r = it;
    if (r >= CN_SMALL) { r -= CN_SMALL; const int mat = r / CI_E, e = mat < 2 * NE ? mat / 2 : mat - 2 * NE, w = mat < 2 * NE ? mat % 2 : 2; r -= mat * CI_E;
        if (w == 0) cvt_job(j, args.in[12] + (size_t)e * D * DFE, D, DFE, ws + WS_WGUE + e * SZ_WGUE, 1, 1, SW1_8, r);
        else if (w == 1) cvt_job(j, args.in[13] + (size_t)e * D * DFE, D, DFE, ws + WS_WGUE + e * SZ_WGUE, 2, 1, SW1_8, r);
        else cvt_job(j, args.in[14] + (size_t)e * DFE * D, DFE, D, ws + WS_WDE + e * SZ_WDE, 0, 1, SW2_8, r);
        return; }
    if (r < 2 * CI_IN) { const int l = r / CI_IN; cvt_job(j, args.in[2] + (size_t)l * D * DIN, D, DIN, ws + WS_WIN + l * SZ_WIN, 0, 0, 1.f, r % CI_IN, l == 1 ? args.in[1] + D : nullptr); return; } r -= 2 * CI_IN;
    if (r < 2 * CI_OUT) { const int l = r / CI_OUT; cvt_job(j, args.in[6] + (size_t)l * D * D, D, D, ws + WS_WOUT + l * SZ_WOUT, 0, 0, 1.f, r % CI_OUT, args.in[5] + l * DATT);
        j.k0 = (j.k0 + DPOOL) & (D - 1); j.gkmax = DATT; return; } r -= 2 * CI_OUT;
    if (r < CI_G) { cvt_job(j, args.in[8], D, DFF, ws + WS_WGU, 1, 0, 1.f, r, args.in[7]); return; } r -= CI_G;
    if (r < CI_G) { cvt_job(j, args.in[9], D, DFF, ws + WS_WGU, 2, 0, 1.f, r, args.in[7]); return; } r -= CI_G;
    if (r < CI_D) { cvt_job(j, args.in[10], DFF, D, ws + WS_WD, 0, 1, SW2_8, r); return; } r -= CI_D;
    { const int mat = r / CI_P; cvt_job(j, args.in[3] + (size_t)mat * PGRP * PGRP, PGRP, PGRP, ws + WS_WPOOL + (size_t)mat * PGRP * PGRP * 2, 0, 0, 1.f, r % CI_P); j.frag = 1; }
}
__device__ __forceinline__ void cvt_range(Frame& F, const Args& args, int it0, int end, int stride) {
    PHASE_IDS();
    LAS float* scr = (LAS float*)(F.lds + RING_OFF) + ph_wave * (64 * 65 + 32);
    int it = it0;
    if (it < end) {
        CvtJob cur, nxt; f32x4 va[16], vb[16];
        cvt_decode(cur, args, args.ws, it); cvt_load(cur, va, ph_lane);
        for (;;) {
            const int ni = it + stride; const bool has = ni < end;
            if (has) { cvt_decode(nxt, args, args.ws, ni); cvt_load(nxt, vb, ph_lane); }
            __builtin_amdgcn_sched_barrier(0);
            cvt_store(cur, va, scr, ph_lane);
            if (!has) break;
            cur = nxt; it = ni;
#pragma unroll
            for (int i = 0; i < 16; ++i) va[i] = vb[i];
        }
    }
}
constexpr int GU_G = 208, CN_DEFER = (256 - GU_G) * NWAVES * DEFER_PER_WAVE;
constexpr int GU_UNITS = (M / 256) * (2 * DFF / 256), GU_TAIL0 = GU_UNITS - (GU_UNITS / GU_G) * GU_G, GU_TAILW = GU_G - GU_TAIL0, CN_DEFER2 = GU_TAILW * NWAVES * DEFER_TAIL;
constexpr int MG_G = 240, CN_DEFER3 = (256 - MG_G) * NWAVES * DEFER_MOE;
static_assert(CN_DEFER + CN_DEFER2 + CN_DEFER3 <= 24 * CI_E, "only expert-weight tiles are deferred (the other weights are needed before the dense gate/up phase)");
static_assert(CN_DEFER3 <= NE * CI_E, "the tiles left to the expert gate/up phase must all be down-projection tiles (that phase itself reads the gate/up weights)");
__device__ __forceinline__ bool defer_on(const Frame& F) { return F.G == 256; }
__device__ __forceinline__ void p0_prologue(Frame& F, const Args& args) {
    PHASE_IDS();
    cvt_range(F, args, F.vcu * NWAVES + ph_wave, defer_on(F) ? CN_ITEMS - CN_DEFER - CN_DEFER2 - CN_DEFER3 : CN_ITEMS, F.G * NWAVES);
    norm_rows(F, args.in[0], args.in[1], (bf16*)(args.ws + WS_XN));
}

typedef float f32x16 __attribute__((ext_vector_type(16)));
__device__ __forceinline__ int crow(int r, int hi) { return (r & 3) + 8 * (r >> 2) + 4 * hi; }
#define MFMA32(a, b, c) __builtin_amdgcn_mfma_f32_32x32x16_bf16((a), (b), (c), 0, 0, 0)
__device__ __forceinline__ bf16x8 pack8(const f32x16& x, int s) {
    v4u p; p.x = cvtpk(x[8 * s + 0], x[8 * s + 1]); p.y = cvtpk(x[8 * s + 2], x[8 * s + 3]); p.z = cvtpk(x[8 * s + 4], x[8 * s + 5]); p.w = cvtpk(x[8 * s + 6], x[8 * s + 7]);
    return __builtin_bit_cast(bf16x8, p);
}
constexpr int ASTB = 136;
constexpr int AT_STATE_BYTES = 512 * ASTB, AT_STAGE_BYTES = 8192;
__device__ __forceinline__ void at_geom(int it, int w, int& dil, int& base, int& blk) { const int pass = it >> 1, idx = w + 8 * (it & 1);
    dil = pass == 0 ? 1 : (pass == 1 ? 4 : 16); base = pass == 0 ? 0 : (pass == 1 ? (idx >> 2) : idx); blk = pass == 0 ? idx : (pass == 1 ? (idx & 3) : 0); }
__device__ __forceinline__ void attn_mfma(Frame& F, const bf16* PROJ, bf16* Y, float* SSO) {
    PHASE_IDS();
    LAS unsigned char* S = F.lds;
    const int lane = ph_lane, q = lane & 31, hi = lane >> 5, w = ph_wave;
    LAS unsigned char* stg = F.lds + AT_STATE_BYTES + w * AT_STAGE_BYTES;
    const int srow = lane >> 3, sch = lane & 7;
    LAS unsigned char* stw = stg + srow * 128 + sch * 16;
    const int lch = sch ^ srow;
    const int tq_ = (lane >> 2) & 3, tp_ = lane & 3, tg_ = (lane >> 4) & 1, kk_ = 4 * hi + tq_;
    LAS unsigned char* const vtr0 = stg + 4096 + kk_ * 128 + (((2 * tg_ + (tp_ >> 1)) ^ kk_) * 16) + 8 * (tp_ & 1);
    for (int item = F.vcu; item < BATCH * NH * 8; item += F.G) {
        const int sb = item & 7, h = (item >> 3) & 7, b = item >> 6;
        const char* Pq = (const char*)PROJ + (size_t)b * SEQ * (PPITCH * 2) + (size_t)(DPOOL + h * HD) * 2;
        const char* Pk = Pq + DATT * 2 + lch * 16;
#define AT_GEOM(it_, dil_, base_, blk_) int dil_, base_, blk_; at_geom((it_), w, dil_, base_, blk_)
#define KB_AT(kb_, blk_, tt_) int kb_; { const int r_ = (blk_) % 5 + (tt_); kb_ = 4 - (r_ >= 5 ? r_ - 5 : r_); }
#define ROW_OFF(ko_, itx, ttx) unsigned ko_[4]; { AT_GEOM(itx, dl_, bs_, bk_); KB_AT(kbx_, bk_, ttx) const int jb_ = (512 * sb) / dl_ + 32 * bk_ - 128 + 32 * kbx_ + srow; \
        _Pragma("unroll") for (int i = 0; i < 4; ++i) { int j_ = jb_ + 8 * i; j_ = j_ < 0 ? 0 : j_; ko_[i] = (unsigned)(bs_ + dl_ * j_) * (unsigned)(PPITCH * 2); } }
#define K_LOAD(K_, itx, kbx) do { ROW_OFF(ko_, itx, kbx) _Pragma("unroll") for (int i = 0; i < 4; ++i) K_[i] = *(const GAS bf16x8*)(Pk + ko_[i]); } while (0)
#define V_LOAD(V_, itx, kbx) do { ROW_OFF(ko_, itx, kbx) _Pragma("unroll") for (int i = 0; i < 4; ++i) V_[i] = *(const GAS bf16x8*)(Pk + ko_[i] + DATT * 2); } while (0)
#define Q_LOAD(Q_, itx) do { AT_GEOM(itx, dl_, bs_, bk_); const int lp_ = bs_ + dl_ * (32 * bk_ + q); const char* qrow_ = Pq + (size_t)(512 * sb + lp_) * (PPITCH * 2) + hi * 16; \
        _Pragma("unroll") for (int d0 = 0; d0 < 4; ++d0) Q_[d0] = *(const GAS bf16x8*)(qrow_ + d0 * 32); } while (0)
        bf16x8 rk[4], rk2[4], rv[4];
        K_LOAD(rk, 0, 0); V_LOAD(rv, 0, 0); K_LOAD(rk2, 0, 1);
        for (int it = 0; it < 6; ++it) {
            AT_GEOM(it, dil, base, blk);
            const int pass = it >> 1;
            const int lp = base + dil * (32 * blk + q);
            const int i0 = (512 * sb) / dil + 32 * blk;
            LAS unsigned char* sr = S + lp * ASTB;
            f32x16 o0, o1; float m, l;
            if (pass == 0) {
#pragma unroll
                for (int i = 0; i < 16; ++i) { o0[i] = 0.f; o1[i] = 0.f; }
                m = -1e30f; l = 0.f;
            } else {
#pragma unroll
                for (int g = 0; g < 4; ++g) { const v2u a = *(const LAS v2u*)(sr + (8 * g + 4 * hi) * 2), c4 = *(const LAS v2u*)(sr + (32 + 8 * g + 4 * hi) * 2);
                    o0[4 * g] = bflo(a.x); o0[4 * g + 1] = bfhi(a.x); o0[4 * g + 2] = bflo(a.y); o0[4 * g + 3] = bfhi(a.y); o1[4 * g] = bflo(c4.x); o1[4 * g + 1] = bfhi(c4.x); o1[4 * g + 2] = bflo(c4.y); o1[4 * g + 3] = bfhi(c4.y); }
                m = *(const LAS float*)(sr + 128); l = hi ? 0.f : *(const LAS float*)(sr + 132);
            }
            bf16x8 qf[4];
            Q_LOAD(qf, it);
#define K_EVENT(e_) { _Pragma("unroll") for (int i = 0; i < 4; ++i) *(LAS bf16x8*)(stw + 1024 * i) = rk[i]; \
                __builtin_amdgcn_sched_barrier(0); \
                _Pragma("unroll") for (int i = 0; i < 4; ++i) rk[i] = rk2[i]; \
                { const int nit = it + ((e_) + 2) / 5, ntt = ((e_) + 2) % 5; if (nit < 6) K_LOAD(rk2, nit, ntt); } \
                __builtin_amdgcn_sched_barrier(0); }
#define QK_TO(S_) { bf16x8 kc[4]; \
                _Pragma("unroll") for (int d0 = 0; d0 < 4; ++d0) { const int pc = ((2 * d0 + hi) ^ (q & 7)) * 16; kc[d0] = *(const LAS bf16x8*)(stg + q * 128 + pc); } \
                _Pragma("unroll") for (int i = 0; i < 16; ++i) S_[i] = 0.f; \
                _Pragma("unroll") for (int d0 = 0; d0 < 4; ++d0) S_ = MFMA32(kc[d0], qf[d0], S_); }
            f32x16 sbuf[2];
            K_EVENT(0) { KB_AT(kb0_, blk, 0) if (i0 - 128 + 32 * kb0_ + 31 >= 0) QK_TO(sbuf[0]) }
#pragma unroll
            for (int kbi = 0; kbi < 5; ++kbi) {
                KB_AT(kb, blk, kbi)
                const int jb = i0 - 128 + 32 * kb;
                if (kbi < 4) { K_EVENT(kbi + 1) KB_AT(kbn_, blk, kbi + 1) if (i0 - 128 + 32 * kbn_ + 31 >= 0) QK_TO(sbuf[(kbi + 1) & 1]) }
                if (jb + 31 >= 0) {
                    f32x16& s = sbuf[kbi & 1];
                    if (kb == 0 || kb == 4 || jb < 0) {
                        int lo = kb == 0 ? q : 0; lo = lo > -jb ? lo : -jb; const int hb = kb == 4 ? q : 31;
#pragma unroll
                        for (int i = 0; i < 16; ++i) { const int c = crow(i, hi); s[i] = (c >= lo && c <= hb) ? s[i] : -3.0e38f; }
                    }
                    float bm = s[0];
#pragma unroll
                    for (int i = 1; i < 16; ++i) bm = fmaxf(bm, s[i]);
                    bm = fmaxf(bm, __shfl_xor(bm, 32));
                    const float mn = fmaxf(m, bm), sc = __builtin_amdgcn_exp2f(m - mn);
                    m = mn;
                    float ps = 0.f;
#pragma unroll
                    for (int i = 0; i < 16; ++i) { s[i] = __builtin_amdgcn_exp2f(s[i] - mn); ps += s[i]; }
                    l = l * sc + ps;
#pragma unroll
                    for (int i = 0; i < 16; ++i) { o0[i] *= sc; o1[i] *= sc; }
                    const bf16x8 pb0 = pack8(s, 0), pb1 = pack8(s, 1);
#pragma unroll
                    for (int i = 0; i < 4; ++i) *(LAS bf16x8*)(stw + 4096 + 1024 * i) = rv[i];
                    __builtin_amdgcn_sched_barrier(0);
                    { const int nit = it + (kbi + 1) / 5, ntt = (kbi + 1) % 5; if (nit < 6) V_LOAD(rv, nit, ntt); }
                    __builtin_amdgcn_sched_barrier(0);
                    { s16x4 va_[2][2][2];
                      asm volatile("ds_read_b64_tr_b16 %0, %8\n\tds_read_b64_tr_b16 %1, %8 offset:1024\n\tds_read_b64_tr_b16 %2, %8 offset:2048\n\tds_read_b64_tr_b16 %3, %8 offset:3072\n\t"
                                   "ds_read_b64_tr_b16 %4, %9\n\tds_read_b64_tr_b16 %5, %9 offset:1024\n\tds_read_b64_tr_b16 %6, %9 offset:2048\n\tds_read_b64_tr_b16 %7, %9 offset:3072\n\t"
                                   "s_waitcnt lgkmcnt(0)"
                                   : "=&v"(va_[0][0][0]), "=&v"(va_[0][0][1]), "=&v"(va_[0][1][0]), "=&v"(va_[0][1][1]), "=&v"(va_[1][0][0]), "=&v"(va_[1][0][1]), "=&v"(va_[1][1][0]), "=&v"(va_[1][1][1])
                                   : "v"(vtr0), "v"(vtr0 + 64 - 2 * (((2 * tg_ + (tp_ >> 1)) ^ kk_) & 4) * 16) : "memory");
#define TR_PK(X_) (bf16x8){X_[0][0], X_[0][1], X_[0][2], X_[0][3], X_[1][0], X_[1][1], X_[1][2], X_[1][3]}
                      o0 = MFMA32(TR_PK(va_[0][0]), pb0, o0); o1 = MFMA32(TR_PK(va_[1][0]), pb0, o1);
                      o0 = MFMA32(TR_PK(va_[0][1]), pb1, o0); o1 = MFMA32(TR_PK(va_[1][1]), pb1, o1);
#undef TR_PK
                    }
                } else { const int nit = it + (kbi + 1) / 5, ntt = (kbi + 1) % 5; if (nit < 6) V_LOAD(rv, nit, ntt); }
            }
            const float lt = l + __shfl_xor(l, 32);
            if (pass == 2) { const float il = 1.f / lt;
#pragma unroll
                for (int i = 0; i < 16; ++i) { o0[i] *= il; o1[i] *= il; } }
#pragma unroll
            for (int g = 0; g < 4; ++g) { v2u a, c4; a.x = cvtpk(o0[4 * g], o0[4 * g + 1]); a.y = cvtpk(o0[4 * g + 2], o0[4 * g + 3]); c4.x = cvtpk(o1[4 * g], o1[4 * g + 1]); c4.y = cvtpk(o1[4 * g + 2], o1[4 * g + 3]);
                *(LAS v2u*)(sr + (8 * g + 4 * hi) * 2) = a; *(LAS v2u*)(sr + (32 + 8 * g + 4 * hi) * 2) = c4; }
            if (hi == 0) { *(LAS float*)(sr + 128) = m; *(LAS float*)(sr + 132) = lt; }
            if (it & 1) asm volatile("s_waitcnt lgkmcnt(0)\n\ts_barrier" ::: "memory");
        }
#undef AT_GEOM
#undef K_LOAD
#undef V_LOAD
#undef ROW_OFF
#undef Q_LOAD
#undef KB_AT
#undef K_EVENT
#undef QK_TO
        { bf16* Ob = Y + (size_t)(b * SEQ + 512 * sb) * D + h * HD; float* so = SSO + (size_t)(b * SEQ + 512 * sb) * 8 + h;
          int to_ = tid_; asm volatile("" : "+v"(to_));
#pragma unroll
          for (int it = 0; it < 8; ++it) { const int row = it * 64 + (to_ >> 3), ch = to_ & 7; const LAS unsigned char* s8 = S + row * ASTB + 16 * ch;
              const v2u a = *(const LAS v2u*)s8, c4 = *(const LAS v2u*)(s8 + 8);
              v4u wv; wv.x = a.x; wv.y = a.y; wv.z = c4.x; wv.w = c4.y;
              *(GAS v4u*)(Ob + (size_t)row * D + 8 * ch) = wv;
              float sq = (bflo(a.x) * bflo(a.x) + bfhi(a.x) * bfhi(a.x)) + (bflo(a.y) * bflo(a.y) + bfhi(a.y) * bfhi(a.y)) + (bflo(c4.x) * bflo(c4.x) + bfhi(c4.x) * bfhi(c4.x)) + (bflo(c4.y) * bflo(c4.y) + bfhi(c4.y) * bfhi(c4.y));
              sq += __shfl_xor(sq, 1); sq += __shfl_xor(sq, 2); sq += __shfl_xor(sq, 4);
              if (ch == 0) so[(size_t)row * 8] = sq; } }
        asm volatile("s_waitcnt lgkmcnt(0)\n\ts_barrier" ::: "memory");
    }
}

__device__ __forceinline__ short small_int_bf16(int v) { return (short)(__float_as_uint((float)v) >> 16); }
__device__ __forceinline__ void pool_mfma(Frame& F, const bf16* PROJ, const bf16* WPT, const float* pscale, bf16* Y) {
    PHASE_IDS();
    const int lane = ph_lane, q = lane & 31, hi = lane >> 5, w = ph_wave, g = w >> 1, eh = w & 1, win = 2 << g;
    LAS float* part = (LAS float*)F.lds;
    LAS unsigned char* const T0 = F.lds + 1024 + w * 16384; LAS unsigned char* const T1 = T0 + 8192;
    const int ch0 = 128 * g + 64 * eh;
    const int srow_ = lane >> 4, sch_ = lane & 15;
    bf16x8 wf[2][8];
    { const char* wb = (const char*)WPT + (size_t)((g * 2 + eh) * 16) * 1024 + lane * 16;
#pragma unroll
      for (int eb = 0; eb < 2; ++eb)
#pragma unroll
          for (int ks = 0; ks < 8; ++ks) wf[eb][ks] = *(const GAS bf16x8*)(wb + (eb * 8 + ks) * 1024); }
    for (int run = F.vcu; run < M / 64; run += F.G) {
        const int row0 = run * 64, p0 = row0 % SEQ;
        bf16x8 ra[8], rb[8];
#define U_LOAD(R_, r_) do { const char* up_ = (const char*)PROJ + (size_t)((r_) + srow_) * (PPITCH * 2) + (size_t)(128 * g) * 2 + sch_ * 16; \
        _Pragma("unroll") for (int i = 0; i < 8; ++i) R_[i] = *(const GAS bf16x8*)(up_ + (size_t)(4 * i) * (PPITCH * 2)); } while (0)
#define U_STAGE(T_, R_) do { _Pragma("unroll") for (int i = 0; i < 8; ++i) *(LAS bf16x8*)(T_ + (srow_ + 4 * i) * 256 + ((sch_ ^ ((srow_ + 4 * i) & 15)) * 16)) = R_[i]; } while (0)
#define U_GEMM(GA_, T_) do { _Pragma("unroll") for (int eb = 0; eb < 2; ++eb) _Pragma("unroll") for (int i = 0; i < 16; ++i) GA_[eb][i] = 0.f; \
        _Pragma("unroll") for (int ks = 0; ks < 8; ++ks) { const bf16x8 uf = *(const LAS bf16x8*)(T_ + q * 256 + (((2 * ks + hi) ^ (q & 15)) * 16)); \
            _Pragma("unroll") for (int eb = 0; eb < 2; ++eb) GA_[eb] = MFMA32(uf, wf[eb][ks], GA_[eb]); } } while (0)
        if (p0 > 0) U_LOAD(ra, row0 - 32);
        U_LOAD(rb, row0);
        bf16x8 gp[2];
#pragma unroll
        for (int eb = 0; eb < 2; ++eb)
#pragma unroll
            for (int j = 0; j < 8; ++j) gp[eb][j] = 0;
        if (p0 > 0) { U_STAGE(T0, ra); }
        U_STAGE(T1, rb);
        U_LOAD(ra, row0 + 32);
        if (p0 > 0) { f32x16 ga[2]; U_GEMM(ga, T0); gp[0] = pack8(ga[0], 1); gp[1] = pack8(ga[1], 1); }
#define POOL_TILE(T_, tt) { \
            const int r0 = row0 + 32 * (tt), pp = p0 + 32 * (tt); \
            f32x16 ga[2]; U_GEMM(ga, T_); \
            const int cnt = (pp + q + 1) < win ? (pp + q + 1) : win; \
            bf16x8 pmo[2], pmp; \
            _Pragma("unroll") for (int s2 = 0; s2 < 2; ++s2) _Pragma("unroll") for (int j = 0; j < 8; ++j) { const int tp = 16 * s2 + 8 * (j >> 2) + 4 * hi + (j & 3); int v = (tp <= q && tp >= q - win + 1) ? 1 : 0; if (tp == q) v -= cnt; pmo[s2][j] = small_int_bf16(v); } \
            _Pragma("unroll") for (int j = 0; j < 8; ++j) { const int tp = 16 + 8 * (j >> 2) + 4 * hi + (j & 3); pmp[j] = (pp > 0 && tp - 32 >= q - win + 1) ? (short)0x3F80 : (short)0; } \
            f32x16 z[2]; float ss = 0.f; const float ic = 1.f / (float)cnt; \
            _Pragma("unroll") for (int eb = 0; eb < 2; ++eb) { \
                _Pragma("unroll") for (int i = 0; i < 16; ++i) z[eb][i] = 0.f; \
                const bf16x8 a0 = pack8(ga[eb], 0), a1 = pack8(ga[eb], 1); \
                z[eb] = MFMA32(a0, pmo[0], z[eb]); z[eb] = MFMA32(a1, pmo[1], z[eb]); z[eb] = MFMA32(gp[eb], pmp, z[eb]); \
                gp[eb] = a1; \
                _Pragma("unroll") for (int i = 0; i < 16; ++i) { z[eb][i] *= ic; ss += z[eb][i] * z[eb][i]; } } \
            ss += __shfl_xor(ss, 32); \
            if (hi == 0) part[w * 32 + q] = ss; \
            __syncthreads(); \
            float tot = 0.f; \
            _Pragma("unroll") for (int k = 0; k < 8; ++k) tot += part[k * 32 + q]; \
            const float ra_ = 1.f / sqrtf(tot * (1.f / DPOOL) + EPS); \
              \
            _Pragma("unroll") for (int eb = 0; eb < 2; ++eb) _Pragma("unroll") for (int gq = 0; gq < 4; ++gq) { const f32x4 p4 = *(const GAS f32x4*)(pscale + ch0 + 32 * eb + 8 * gq + 4 * hi); v2u wv; \
                wv.x = cvtpk(z[eb][4 * gq] * ra_ * p4.x, z[eb][4 * gq + 1] * ra_ * p4.y); wv.y = cvtpk(z[eb][4 * gq + 2] * ra_ * p4.z, z[eb][4 * gq + 3] * ra_ * p4.w); \
                *(LAS v2u*)(T_ + q * 128 + (((4 * eb + gq) ^ (q & 7)) * 16) + 8 * hi) = wv; } \
            _Pragma("unroll") for (int i = 0; i < 4; ++i) { const int orow = (lane >> 3) + 8 * i, oc = lane & 7; \
                const v4u ov = *(const LAS v4u*)(T_ + orow * 128 + ((oc ^ (orow & 7)) * 16)); \
                *(GAS v4u*)(Y + (size_t)(r0 + orow) * D + DATT + ch0 + 8 * oc) = ov; } \
            __syncthreads(); }
        POOL_TILE(T1, 0)
        U_STAGE(T0, ra);
        POOL_TILE(T0, 1)
#undef POOL_TILE
#undef U_GEMM
#undef U_STAGE
#undef U_LOAD
    }
}

__device__ __forceinline__ void norm_router(Frame& F, const bf16* X, const float* gain, const float* wrt, unsigned char* XS, int* tokinfo, unsigned* gcnt) {
    PHASE_IDS();
    LAS float* wl = (LAS float*)(F.lds + RING_OFF);
    LAS int* lcnt = (LAS int*)(F.lds + RING_OFF + 40960); LAS int* lbase = lcnt + 8; LAS int* stash = lcnt + 16;
    LAS unsigned char* rows8 = F.lds + RING_OFF + 49152;
    const int lane = ph_lane;
    v2u xw[8][4];
#define RT_LOAD(ch_) _Pragma("unroll") for (int r8 = 0; r8 < 8; ++r8) { const GAS v2u* xr = (const GAS v2u*)(X + (size_t)((ch_) * 64 + ph_wave * 8 + r8) * D) + lane; \
        _Pragma("unroll") for (int j = 0; j < 4; ++j) xw[r8][j] = xr[64 * j]; }
    if (F.vcu < M / 64) { RT_LOAD(F.vcu) }
    for (int k = tid_; k < D; k += NWAVES * 64) { const f32x4 a = *(const GAS f32x4*)(wrt + 8 * k), b = *(const GAS f32x4*)(wrt + 8 * k + 4);
        *(LAS f32x4*)(wl + 8 * k + 4 * (k >> 2)) = a; *(LAS f32x4*)(wl + 8 * k + 4 * (k >> 2) + 4) = b; }
    f32x4 g[4];
#pragma unroll
    for (int j = 0; j < 4; ++j) g[j] = ((const GAS f32x4*)gain)[lane + 64 * j];
    for (int ch = F.vcu; ch < M / 64; ch += F.G) {
        if (ch != F.vcu) { RT_LOAD(ch) }
        if (tid_ < 8) lcnt[tid_] = 0;
        __syncthreads();
#pragma unroll
        for (int rb4 = 0; rb4 < 8; rb4 += 4) {
            f32x4 vv[4][4];
#pragma unroll
            for (int r4 = 0; r4 < 4; ++r4)
#pragma unroll
                for (int j = 0; j < 4; ++j) { const v2u w = xw[rb4 + r4][j]; vv[r4][j] = (f32x4){bflo(w.x), bfhi(w.x), bflo(w.y), bfhi(w.y)}; }
#pragma unroll
            for (int r4 = 0; r4 < 4; ++r4) {
                const int lr = ph_wave * 8 + rb4 + r4;
                float s = 0.f;
#pragma unroll
                for (int j = 0; j < 4; ++j) { const f32x4 x = vv[r4][j]; s += (x.x * x.x + x.y * x.y) + (x.z * x.z + x.w * x.w); }
                const float r = 1.f / sqrtf(wave_sum(s) * (1.f / D) + EPS);
                LAS unsigned* o4 = (LAS unsigned*)(rows8 + lr * 1024) + lane;
                float lg[8];
#pragma unroll
                for (int e = 0; e < 8; ++e) lg[e] = 0.f;
#pragma unroll
                for (int j = 0; j < 4; ++j) { const f32x4 h = vv[r4][j] * r * g[j]; o4[64 * j] = cvt4_fp8(h.x * SX8, h.y * SX8, h.z * SX8, h.w * SX8);
#pragma unroll
                    for (int i = 0; i < 4; ++i) { const int k = 4 * lane + 256 * j + i; const f32x4 a = *(const LAS f32x4*)(wl + 8 * k + 4 * (k >> 2)), b = *(const LAS f32x4*)(wl + 8 * k + 4 * (k >> 2) + 4);
                        const float hv = h[i]; lg[0] += hv * a.x; lg[1] += hv * a.y; lg[2] += hv * a.z; lg[3] += hv * a.w; lg[4] += hv * b.x; lg[5] += hv * b.y; lg[6] += hv * b.z; lg[7] += hv * b.w; } }
                float a4[4];
#pragma unroll
                for (int j = 0; j < 4; ++j) { const float keep = (lane & 1) ? lg[2 * j + 1] : lg[2 * j], send = (lane & 1) ? lg[2 * j] : lg[2 * j + 1]; a4[j] = keep + __shfl_xor(send, 1); }
                float a2[2];
#pragma unroll
                for (int j = 0; j < 2; ++j) { const float keep = (lane & 2) ? a4[2 * j + 1] : a4[2 * j], send = (lane & 2) ? a4[2 * j] : a4[2 * j + 1]; a2[j] = keep + __shfl_xor(send, 2); }
                float a1; { const float keep = (lane & 4) ? a2[1] : a2[0], send = (lane & 4) ? a2[0] : a2[1]; a1 = keep + __shfl_xor(send, 4); }
                a1 += __shfl_xor(a1, 8); a1 += __shfl_xor(a1, 16); a1 += __shfl_xor(a1, 32);
#pragma unroll
                for (int e = 0; e < 8; ++e) lg[e] = __shfl(a1, e);
                int e0 = 0; float v0 = lg[0];
#pragma unroll
                for (int e = 1; e < 8; ++e) if (lg[e] > v0) { v0 = lg[e]; e0 = e; }
                int e1 = -1; float v1 = -3.0e38f;
#pragma unroll
                for (int e = 0; e < 8; ++e) if (e != e0 && lg[e] > v1) { v1 = lg[e]; e1 = e; }
                const float ex = expf(v1 - v0), g0 = 1.f / (1.f + ex), g1 = ex * g0;
                if (lane == 0) { const int p0 = __hip_atomic_fetch_add(lcnt + e0, 1, __ATOMIC_RELAXED, __HIP_MEMORY_SCOPE_WORKGROUP), p1 = __hip_atomic_fetch_add(lcnt + e1, 1, __ATOMIC_RELAXED, __HIP_MEMORY_SCOPE_WORKGROUP);
                    stash[lr * 6 + 0] = e0; stash[lr * 6 + 1] = e1; stash[lr * 6 + 2] = p0; stash[lr * 6 + 3] = p1; stash[lr * 6 + 4] = __float_as_int(g0); stash[lr * 6 + 5] = __float_as_int(g1); }
            }
        }
        __syncthreads();
        if (tid_ < 8) lbase[tid_] = (int)__hip_atomic_fetch_add(gcnt + tid_, (unsigned)lcnt[tid_], RLX_AGENT);
        __syncthreads();
        for (int rr = 0; rr < 8; ++rr) {
            const int lr = ph_wave * 8 + rr, m = ch * 64 + lr;
            const int e0 = stash[lr * 6], e1 = stash[lr * 6 + 1]; const int p0 = lbase[e0] + stash[lr * 6 + 2], p1 = lbase[e1] + stash[lr * 6 + 3];
            const v4u rowv = *(const LAS v4u*)(rows8 + lr * 1024 + lane * 16);
            *(GAS v4u*)(XS + ((size_t)e0 * M + p0) * D + lane * 16) = rowv;
            *(GAS v4u*)(XS + ((size_t)e1 * M + p1) * D + lane * 16) = rowv;
            if (lane == 0) { int* ti = tokinfo + (size_t)m * 8; ti[0] = e0; ti[1] = e1; ti[2] = p0; ti[3] = p1; ti[4] = stash[lr * 6 + 4]; ti[5] = stash[lr * 6 + 5]; }
        }
        __syncthreads();
    }
}

__device__ __forceinline__ void final_phase(Frame& F, const bf16* X, float* OUT, const bf16* YM, const int* tokinfo, const unsigned* gcnt, const float* gain, const int* ovf, const bf16* SLAB) {
    const int tid_ = F.wave * 64 + lane_id(), ph_lane = tid_ & 63, ph_wave = F.wave; (void)ph_lane; (void)ph_wave;
    const int gw = F.vcu * NWAVES + ph_wave, NGW = F.G * NWAVES, lane = ph_lane;
    int ts[NE + 1]; ts[0] = 0;
#pragma unroll
    for (int e = 0; e < NE; ++e) { const int c = (int)__builtin_amdgcn_readfirstlane(gcnt[e]); ts[e + 1] = ts[e] + (c + 255) / 256; }
    f32x4 g[4];
#pragma unroll
    for (int j = 0; j < 4; ++j) g[j] = ((const GAS f32x4*)gain)[lane + 64 * j];
    int ovS = 1; { const int U = ts[NE] * (D / 256), Rr = U - (U / F.G) * F.G; ovS = (Rr > 0 && Rr * 7 <= F.G) ? 7 : ((Rr > 0 && Rr * 2 <= F.G) ? 2 : 1); }
    for (int mb = gw; mb < M; mb += 4 * NGW) {
        int mr = mb + (lane & 3) * NGW; mr = mr < M ? mr : mb;
        const v4u t0 = *(const GAS v4u*)(tokinfo + (size_t)mr * 8); const v2u t1 = *(const GAS v2u*)(tokinfo + (size_t)mr * 8 + 4);
        v2u xv[4][4]; f32x4 v[4][4]; v2u ya[4][4], yb[4][4]; float g0[4], g1[4]; int rr0[4], rr1[4]; v4u oa[4], ob[4];
#pragma unroll
        for (int r = 0; r < 4; ++r) {
            const int m = (mb + r * NGW < M) ? mb + r * NGW : mb;
            const int e0 = __builtin_amdgcn_readlane((int)t0.x, r), e1 = __builtin_amdgcn_readlane((int)t0.y, r), p0 = __builtin_amdgcn_readlane((int)t0.z, r), p1 = __builtin_amdgcn_readlane((int)t0.w, r);
            g0[r] = __int_as_float(__builtin_amdgcn_readlane((int)t1.x, r)); g1[r] = __int_as_float(__builtin_amdgcn_readlane((int)t1.y, r));
            int t0s = 0, t1s = 0;
#pragma unroll
            for (int e = 0; e < NE; ++e) { t0s = (e0 == e) ? ts[e] : t0s; t1s = (e1 == e) ? ts[e] : t1s; }
            const size_t r0 = (size_t)t0s * 256 + p0, r1 = (size_t)t1s * 256 + p1; rr0[r] = (int)r0; rr1[r] = (int)r1; oa[r] = *(const GAS v4u*)(ovf + (r0 >> 8) * 4); ob[r] = *(const GAS v4u*)(ovf + (r1 >> 8) * 4);
            const GAS v2u* xr = (const GAS v2u*)(X + (size_t)m * D) + lane;
            const GAS v2u* y0 = (const GAS v2u*)(YM + r0 * D) + lane; const GAS v2u* y1 = (const GAS v2u*)(YM + r1 * D) + lane;
#pragma unroll
            for (int j = 0; j < 4; ++j) { xv[r][j] = xr[64 * j]; ya[r][j] = y0[64 * j]; yb[r][j] = y1[64 * j]; }
        }
#pragma unroll
        for (int r = 0; r < 4; ++r) {
            const int m = mb + r * NGW;
            if (m < M) {
                float s = 0.f;
                const unsigned anyov = (ovS > 1) ? (unsigned)__builtin_amdgcn_readfirstlane((int)(oa[r].x | oa[r].y | oa[r].z | oa[r].w | ob[r].x | ob[r].y | ob[r].z | ob[r].w)) : 0u;
                if (anyov == 0u) {
#pragma unroll
                    for (int j = 0; j < 4; ++j) { const v2u a = ya[r][j], b2 = yb[r][j]; const v2u xw_ = xv[r][j]; f32x4 x = (f32x4){bflo(xw_.x), bfhi(xw_.x), bflo(xw_.y), bfhi(xw_.y)};
                        x.x += g0[r] * bflo(a.x) + g1[r] * bflo(b2.x); x.y += g0[r] * bfhi(a.x) + g1[r] * bfhi(b2.x); x.z += g0[r] * bflo(a.y) + g1[r] * bflo(b2.y); x.w += g0[r] * bfhi(a.y) + g1[r] * bfhi(b2.y);
                        v[r][j] = x; s += (x.x * x.x + x.y * x.y) + (x.z * x.z + x.w * x.w); }
                } else {
#pragma unroll
                    for (int j = 0; j < 4; ++j) { const v2u a = ya[r][j], b2 = yb[r][j]; const v2u xw_ = xv[r][j]; f32x4 x = (f32x4){bflo(xw_.x), bfhi(xw_.x), bflo(xw_.y), bfhi(xw_.y)};
                        f32x4 fa = (f32x4){bflo(a.x), bfhi(a.x), bflo(a.y), bfhi(a.y)}, fb = (f32x4){bflo(b2.x), bfhi(b2.x), bflo(b2.y), bfhi(b2.y)};
                        const int ea = __builtin_amdgcn_readfirstlane((int)oa[r][j]), eb = __builtin_amdgcn_readfirstlane((int)ob[r][j]);
                        if (ea) { fa = (f32x4){0.f, 0.f, 0.f, 0.f}; for (int sl = 0; sl < ovS; ++sl) { const v2u w = *((const GAS v2u*)(SLAB + ((size_t)((ea - 1) * ovS + sl) * 256 + (rr0[r] & 255)) * 256) + lane); fa += (f32x4){bflo(w.x), bfhi(w.x), bflo(w.y), bfhi(w.y)}; } }
                        if (eb) { fb = (f32x4){0.f, 0.f, 0.f, 0.f}; for (int sl = 0; sl < ovS; ++sl) { const v2u w = *((const GAS v2u*)(SLAB + ((size_t)((eb - 1) * ovS + sl) * 256 + (rr1[r] & 255)) * 256) + lane); fb += (f32x4){bflo(w.x), bfhi(w.x), bflo(w.y), bfhi(w.y)}; } }
                        x = x + fa * g0[r] + fb * g1[r];
                        v[r][j] = x; s += (x.x * x.x + x.y * x.y) + (x.z * x.z + x.w * x.w); }
                }
                const float rr = 1.f / sqrtf(wave_sum(s) * (1.f / D) + EPS);
                GAS f32x4* xw = (GAS f32x4*)(OUT + (size_t)m * D) + lane;
#pragma unroll
                for (int j = 0; j < 4; ++j) __builtin_nontemporal_store(v[r][j] * rr * g[j], xw + 64 * j);
            }
        }
    }
}

constexpr int NPH = 13;
__global__ void __launch_bounds__(NWAVES * 64, 2) trunk_fwd(Args args) {
    extern __shared__ __attribute__((aligned(16))) unsigned char lds[];
    Frame F;
    F.lds = (LAS unsigned char*)lds;
    F.MISC = (volatile LAS unsigned*)(F.lds + MISC_OFF);
    F.wave = __builtin_amdgcn_readfirstlane((int)threadIdx.x >> 6);
    F.G = gridDim.x; { const int bx = blockIdx.x; F.vcu = (F.G % 8 == 0) ? (bx % 8) * (F.G / 8) + bx / 8 : bx; }
    F.ctl = (gu32*)(args.ws + WS_CTL);
    for (int u = threadIdx.x; u < (LDS_BYTES - LDSCTL_OFF) / 4; u += NWAVES * 64) ((LAS unsigned*)(F.lds + LDSCTL_OFF))[u] = 0u;
    __syncthreads();
#if MK_ONE_LAUNCH
    (void)xcd_barrier_post((unsigned*)(F.ctl + CW_BAR), F.MISC + 8);
#define GRID_BAR() do { XcdBarrier bar_; bar_.bar = (unsigned*)(F.ctl + CW_BAR); bar_.x = xb_xcc_id(); bar_.st = F.MISC + 8; xcd_barrier(bar_, F.wave == 0 && lane_id() == 0); } while (0)
#else
#define GRID_BAR() do { } while (0)
#endif
    const int lo = args.ph_lo, hi = args.ph_hi; (void)lo; (void)hi;
#if MK_ONE_LAUNCH
#define IN(k) true
#else
#define IN(k) (lo <= (k) && (k) < hi)
#endif
#define SEAM(k) do { if (IN(k) && IN((k) + 1)) GRID_BAR(); } while (0)
#define PH_WS() unsigned char* ws = args.ws; asm volatile("" : "+s"(ws))
#define XN ((bf16*)(ws + WS_XN))
#define AR (ws + WS_ARENA)
#define PROJ ((bf16*)(AR + AR_PROJ))
#define OB ((bf16*)(AR + AR_O))
#define YB ((bf16*)(AR + AR_Y))
#define HB ((bf16*)(AR + AR_H))
#define HM ((bf16*)(AR + AR_HM))
#define YM ((bf16*)(AR + AR_YM))
#define tokinfo ((int*)(ws + WS_ROUTE))
#define gcnt ((unsigned*)(F.ctl + CW_ECNT))
#define RTAB ((LAS float*)(F.lds + RING_BYTES + 1024))
    const int c = (int)blockIdx.x;
    LAS unsigned char* ring = F.lds + RING_OFF;

#define PH(k, ...) if (IN(k)) { { PH_WS(); __VA_ARGS__ } if ((PROBE_MASK >> (k)) & 1u) { GRID_BAR(); PH_WS(); __VA_ARGS__ } } SEAM(k);
#define PHL(k, ...) if (IN(k)) { PH_WS(); __VA_ARGS__ }
    PH(0, (void)ws; p0_prologue(F, args);)

#define LAYER_MIX(P, l, EPI_, BASE_, SSW_, X8_) \
    PH((P) + 0, pg8::ProbDense pr{(const char*)XN, (const char*)(ws + WS_WIN + (size_t)(l) * SZ_WIN), D, M / 256, DIN / 256, F.G, c}; \
        pg8::EpiBf16 ep{PROJ, PPITCH, 2, 4, C2, (l) == 0 ? nullptr : (const float*)(ws + WS_SS), RTAB}; pg8::gemm_phase<false>(ring, pr, ep);) \
    PH((P) + 1, attn_mfma(F, PROJ, YB, (float*)(ws + WS_SSO)); \
        pool_mfma(F, PROJ, (const bf16*)(ws + WS_WPOOL) + (size_t)(l) * 4 * PGRP * PGRP, args.in[4] + (l) * DPOOL, YB);) \
    PH((P) + 2, typename pg8::identity_t<void EPI_>::type ep{BASE_, XN, D, SSW_, X8_}; \
        for (int ui_ = 0; ui_ * F.G + c < (M / 256) * (D / 256); ++ui_) { \
            pg8::ProbDense pr{(const char*)YB, (const char*)(ws + WS_WOUT + (size_t)(l) * SZ_WOUT), D, M / 256, D / 256, F.G, c, ui_, 1, (const float*)(ws + WS_SSO), RTAB}; \
            pg8::gemm_phase<false, true>(ring, pr, ep); })

    LAYER_MIX(1, 0, (pg8::EpiRes<true>), (const void*)args.in[0], (float*)(ws + WS_SS), (unsigned char*)nullptr)
    PH(4, if (defer_on(F) && c >= GU_G) { cvt_range(F, args, CN_ITEMS - CN_DEFER3 - CN_DEFER + (c - GU_G) * NWAVES + F.wave, CN_ITEMS - CN_DEFER3, (256 - GU_G) * NWAVES); } else {
        pg8::ProbDense pr{(const char*)XN, (const char*)(ws + WS_WGU), D, M / 256, 2 * DFF / 256, defer_on(F) ? GU_G : F.G, c};
        pg8::EpiSwiGLU8 ep{(unsigned char*)HB, DFF, 1.f, (const float*)(ws + WS_SS), RTAB}; pg8::gemm_phase<false>(ring, pr, ep);
        if (defer_on(F) && c >= GU_TAIL0) { __syncthreads(); cvt_range(F, args, CN_ITEMS - CN_DEFER3 - CN_DEFER - CN_DEFER2 + (c - GU_TAIL0) * NWAVES + F.wave, CN_ITEMS - CN_DEFER3 - CN_DEFER, GU_TAILW * NWAVES); } })
    PH(5, pg8::ProbDense pr{(const char*)HB, (const char*)(ws + WS_WD), DFF / 2, M / 256, D / 256, F.G, c}; pr.ablk = true;
        pg8::EpiRes<false, false, true> ep{(const void*)XN, XN, D, (float*)(ws + WS_SS), nullptr, 1.f / (SH8 * SW2_8)}; pg8::gemm_phase<true>(ring, pr, ep);)
    LAYER_MIX(6, 1, (pg8::EpiRes<false>), (const void*)XN, (float*)nullptr, (unsigned char*)nullptr)
    PH(9, norm_router(F, XN, args.in[7] + D, args.in[11], AR + AR_XS, tokinfo, gcnt);)
#define MOE_SETUP(PR) { LAS int* tab_ = (LAS int*)(F.lds + LDSCTL_OFF + 512); __syncthreads(); if (threadIdx.x == 0) { int acc_ = 0; tab_[0] = 0; for (int e = 0; e < NE; ++e) { const int ce = (int)__hip_atomic_load(gcnt + e, RLX_AGENT); tab_[NE + 1 + e] = ce; acc_ += (ce + 255) / 256; tab_[e + 1] = acc_; } } __syncthreads(); \
        PR.tab = tab_; PR.nT = __builtin_amdgcn_readfirstlane(tab_[NE]); }
    PH(10, if (defer_on(F) && c >= MG_G) { cvt_range(F, args, CN_ITEMS - CN_DEFER3 + (c - MG_G) * NWAVES + F.wave, CN_ITEMS, (256 - MG_G) * NWAVES); } else {
        pg8::ProbMoE<0> pr; pr.A = (const char*)(AR + AR_XS); pr.B = (const char*)(ws + WS_WGUE); pr.bes = SZ_WGUE; pr.K = D / 2; pr.nN = 2 * DFE / 256; pr.G = defer_on(F) ? MG_G : F.G; pr.c = c; MOE_SETUP(pr)
        pg8::EpiSwiGLU8 ep{(unsigned char*)HM, DFE, 1.f / (SX8 * SW1_8)}; pg8::gemm_phase<true>(ring, pr, ep); })
    PH(11, pg8::ProbMoE<1> pr; pr.A = (const char*)HM; pr.B = (const char*)(ws + WS_WDE); pr.bes = SZ_WDE; pr.K = DFE / 2; pr.nN = D / 256; pr.G = F.G; pr.c = c; pr.ovf = (int*)(F.ctl + CW_OVF); MOE_SETUP(pr)
        pg8::EpiBf16 ep{YM, D, 0, 1 << 30, 1.f / (SH8 * SW2_8), nullptr, RTAB, (bf16*)(AR + AR_SLAB)}; pg8::gemm_phase<true>(ring, pr, ep);)
    PHL(12, final_phase(F, XN, args.out, YM, tokinfo, gcnt, args.in[15], (const int*)(F.ctl + CW_OVF), (const bf16*)(AR + AR_SLAB));)
#undef IN
#undef SEAM
}

extern "C" void kernel_launch(void* const* d_in, const int* in_sizes, int n_in, void* d_out, int out_size, void* d_ws, size_t ws_size, hipStream_t stream) {
    static int grid = 0;
    if (grid == 0) {
        if (n_in != 16 || in_sizes[0] != M * D || out_size != M * D || ws_size < WS_END) { fprintf(stderr, "kernel_launch: shape/workspace mismatch (n_in %d, ws %zu, need %zu); nothing launched\n", n_in, ws_size, (size_t)WS_END); grid = -1; return; }
        int dev = 0, cus = 0, per_cu = 0;
        if (hipGetDevice(&dev) != hipSuccess || hipDeviceGetAttribute(&cus, hipDeviceAttributeMultiprocessorCount, dev) != hipSuccess) { grid = -1; return; }
        if (hipFuncSetAttribute((const void*)trunk_fwd, hipFuncAttributeMaxDynamicSharedMemorySize, LDS_BYTES) != hipSuccess) { grid = -1; return; }
        if (hipOccupancyMaxActiveBlocksPerMultiprocessor(&per_cu, (const void*)trunk_fwd, NWAVES * 64, LDS_BYTES) != hipSuccess || per_cu < 1) { fprintf(stderr, "kernel_launch: occupancy query says %d\n", per_cu); }
        (void)hipGetLastError();
        grid = cus;
    }
    if (grid < 0) return;
    if (hipMemsetAsync((char*)d_ws + WS_CTL, 0, CTL_ZERO_BYTES, stream) != hipSuccess) return;
    Args a{};
    for (int i = 0; i < 16; ++i) a.in[i] = (const float*)d_in[i];
    a.out = (float*)d_out; a.ws = (unsigned char*)d_ws;
#if MK_ONE_LAUNCH
    a.ph_lo = 0; a.ph_hi = NPH;
    hipLaunchKernelGGL(trunk_fwd, dim3(grid), dim3(NWAVES * 64), LDS_BYTES, stream, a);
#else
    for (int p = 0; p < NPH; ++p) { a.ph_lo = p; a.ph_hi = p + 1; hipLaunchKernelGGL(trunk_fwd, dim3(grid), dim3(NWAVES * 64), LDS_BYTES, stream, a); }
#endif
}
```
